# Optimizing an MI355X kernel written in HIP

```python
import jax, jax.numpy as jnp
from jax import lax
import numpy as np

D_MODEL = 1024
BATCH = 4
SEQ = 4096
DEPTH = 1

N_META = 16
GRID_W = 64
NA_HEADS = 8
NA_HEAD_DIM = 64
NA_WIN_H = 8
NA_WIN_W = 16
NA_QBLK_W = 16
NA_KBLK_W = 32
NA_W = NA_HEADS * NA_HEAD_DIM
MLA_HEADS = 8
MLA_NOPE_DIM = 64
MLA_ROPE_DIM = 32
MLA_V_DIM = 64
MLA_Q_RANK = 384
MLA_KV_RANK = 256
MLA_QBLK = 128
MLA_W = MLA_HEADS * MLA_V_DIM
ROPE_THETA = 10000.0
D_FF = 4 * D_MODEL
EPS = 1e-6

IN_SIZES = (NA_W, NA_W, NA_W, MLA_Q_RANK, MLA_KV_RANK, MLA_ROPE_DIM, D_MODEL, D_MODEL)
D_IN = sum(IN_SIZES)
IN_SPLITS = tuple(int(s) for s in np.cumsum(IN_SIZES)[:-1])

kernel_name = "hybrid_na_mla_gated_encoder"


def rmsnorm(x, g):
    xf = x.astype(jnp.float32)
    y = xf * lax.rsqrt(jnp.mean(xf * xf, axis=-1, keepdims=True) + EPS)
    return (y * g.astype(jnp.float32)).astype(x.dtype)


def rope(x, cos, sin):
    half = x.shape[-1] // 2
    x1, x2 = x[..., :half], x[..., half:]
    return jnp.concatenate([x1 * cos - x2 * sin, x2 * cos + x1 * sin], axis=-1).astype(x.dtype)


def neighborhood_attention(q, k, v, rpb):
    B, L, H, dh = q.shape
    n_tok = L - N_META
    rows = n_tok // GRID_W
    kh = min(NA_WIN_H, rows)
    scale = dh ** -0.5
    qm, km, vm = q[:, :N_META], k[:, :N_META], v[:, :N_META]
    qg = q[:, N_META:].reshape(B, rows, GRID_W, H, dh)
    kg = k[:, N_META:].reshape(B, rows, GRID_W, H, dh)
    vg = v[:, N_META:].reshape(B, rows, GRID_W, H, dh)

    s_m = jnp.einsum('bqhd,bkhd->bhqk', qm, km, preferred_element_type=jnp.float32) * scale
    p_m = jax.nn.softmax(s_m, axis=-1).astype(vm.dtype)
    out_meta = jnp.einsum('bhqk,bkhd->bqhd', p_m, vm)

    n_cb = GRID_W // NA_QBLK_W
    qcol = np.arange(GRID_W).reshape(n_cb, NA_QBLK_W)
    cstart = np.clip(qcol - NA_WIN_W // 2, 0, GRID_W - NA_WIN_W)
    kb0 = np.clip(np.arange(n_cb) * NA_QBLK_W - NA_WIN_W // 2, 0, GRID_W - NA_KBLK_W)
    kcol = kb0[:, None] + np.arange(NA_KBLK_W)
    kc = kcol[:, None, :]
    cvalid = (kc >= cstart[..., None]) & (kc < cstart[..., None] + NA_WIN_W)
    dc_idx = np.clip(kc - qcol[:, :, None] + NA_WIN_W - 1, 0, 2 * NA_WIN_W - 2)
    bias_c = rpb.astype(jnp.float32)[:, :, dc_idx]
    cvalid_b = jnp.asarray(cvalid)[None, None, :, :, None, :]

    def row_block(r):
        rs = jnp.clip(r - kh // 2, 0, rows - kh)
        k_rows = lax.dynamic_slice_in_dim(kg, rs, kh, axis=1)
        v_rows = lax.dynamic_slice_in_dim(vg, rs, kh, axis=1)
        k_blk = k_rows[:, :, kcol]
        v_blk = v_rows[:, :, kcol]
        q_row = lax.dynamic_index_in_dim(qg, r, axis=1, keepdims=False)
        q_row = q_row.reshape(B, n_cb, NA_QBLK_W, H, dh)
        s_grid = jnp.einsum('bnqhd,banchd->bhnqac', q_row, k_blk,
                            preferred_element_type=jnp.float32) * scale
        dr_idx = rs + jnp.arange(kh) - r + NA_WIN_H - 1
        bias = bias_c[:, dr_idx].transpose(0, 2, 3, 1, 4)
        s_grid = jnp.where(cvalid_b, s_grid + bias[None], -jnp.inf)
        s_grid = s_grid.reshape(B, H, n_cb, NA_QBLK_W, kh * NA_KBLK_W)
        s_meta = jnp.einsum('bnqhd,bmhd->bhnqm', q_row, km,
                            preferred_element_type=jnp.float32) * scale
        p = jax.nn.softmax(jnp.concatenate([s_meta, s_grid], axis=-1), axis=-1).astype(v.dtype)
        p_meta = p[..., :N_META]
        p_grid = p[..., N_META:].reshape(B, H, n_cb, NA_QBLK_W, kh, NA_KBLK_W)
        out = (jnp.einsum('bhnqm,bmhd->bnqhd', p_meta, vm)
               + jnp.einsum('bhnqac,banchd->bnqhd', p_grid, v_blk))
        return out.reshape(B, GRID_W, H, dh)

    out_grid = lax.map(row_block, jnp.arange(rows))
    out_grid = out_grid.transpose(1, 0, 2, 3, 4).reshape(B, n_tok, H, dh)
    return jnp.concatenate([out_meta, out_grid], axis=1)


def mla_attention(c_q, c_kv, k_rope_raw, q_norm, w_uq, kv_norm, w_ukv, cos, sin):
    B, L, _ = c_q.shape
    H = MLA_HEADS
    q = (rmsnorm(c_q, q_norm) @ w_uq).reshape(B, L, H, MLA_NOPE_DIM + MLA_ROPE_DIM)
    q_nope = q[..., :MLA_NOPE_DIM]
    q_rope = rope(q[..., MLA_NOPE_DIM:], cos[:, None, :], sin[:, None, :])
    kv = (rmsnorm(c_kv, kv_norm) @ w_ukv).reshape(B, L, H, MLA_NOPE_DIM + MLA_V_DIM)
    k_nope, v = kv[..., :MLA_NOPE_DIM], kv[..., MLA_NOPE_DIM:]
    k_rope = rope(k_rope_raw, cos, sin)
    scale = (MLA_NOPE_DIM + MLA_ROPE_DIM) ** -0.5

    def attend(qn, qr):
        s = (jnp.einsum('bqhd,bkhd->bhqk', qn, k_nope, preferred_element_type=jnp.float32)
             + jnp.einsum('bqhr,bkr->bhqk', qr, k_rope, preferred_element_type=jnp.float32)) * scale
        p = jax.nn.softmax(s, axis=-1).astype(v.dtype)
        return jnp.einsum('bhqk,bkhd->bqhd', p, v)

    out_meta = attend(q_nope[:, :N_META], q_rope[:, :N_META])
    n_tok = L - N_META
    n_blk = n_tok // MLA_QBLK
    qn_b = q_nope[:, N_META:].reshape(B, n_blk, MLA_QBLK, H, MLA_NOPE_DIM).swapaxes(0, 1)
    qr_b = q_rope[:, N_META:].reshape(B, n_blk, MLA_QBLK, H, MLA_ROPE_DIM).swapaxes(0, 1)
    out_blk = lax.map(lambda t: attend(t[0], t[1]), (qn_b, qr_b))
    out_blk = out_blk.swapaxes(0, 1).reshape(B, n_tok, H, MLA_V_DIM)
    return jnp.concatenate([out_meta, out_blk], axis=1).reshape(B, L, MLA_W)


def setup_inputs(seed: int = 0) -> dict:
    key = jax.random.key(seed)
    ks = jax.random.split(key, 18)
    f32 = jnp.float32

    def w(k, shape, fan_in):
        return jax.random.normal(k, shape, f32) * (fan_in ** -0.5)

    def gain(k, shape):
        return 1.0 + 0.05 * jax.random.normal(k, shape, f32)

    return {
        "x": jax.random.normal(ks[0], (BATCH, SEQ, D_MODEL), f32),
        "meta": jax.random.normal(ks[1], (N_META, D_MODEL), f32),
        "norm_mix": gain(ks[2], (DEPTH, D_MODEL)),
        "w_in": w(ks[3], (DEPTH, D_MODEL, D_IN), D_MODEL),
        "na_rpb": 0.1 * jax.random.normal(ks[4], (DEPTH, NA_HEADS, 2 * NA_WIN_H - 1, 2 * NA_WIN_W - 1), f32),
        "mla_q_norm": gain(ks[5], (DEPTH, MLA_Q_RANK)),
        "w_uq": w(ks[6], (DEPTH, MLA_Q_RANK, MLA_HEADS * (MLA_NOPE_DIM + MLA_ROPE_DIM)), MLA_Q_RANK),
        "mla_kv_norm": gain(ks[7], (DEPTH, MLA_KV_RANK)),
        "w_ukv": w(ks[8], (DEPTH, MLA_KV_RANK, MLA_HEADS * (MLA_NOPE_DIM + MLA_V_DIM)), MLA_KV_RANK),
        "w_na_out": w(ks[9], (DEPTH, NA_W, D_MODEL), NA_W),
        "w_mla_out": w(ks[10], (DEPTH, MLA_W, D_MODEL), MLA_W),
        "w_out": w(ks[11], (DEPTH, D_MODEL, D_MODEL), D_MODEL),
        "norm_ffn": gain(ks[12], (DEPTH, D_MODEL)),
        "w_ff1": w(ks[13], (DEPTH, D_MODEL, D_FF), D_MODEL),
        "w_ff2": w(ks[14], (DEPTH, D_FF, D_MODEL), D_FF),
        "norm_final": gain(ks[15], (D_MODEL,)),
    }


def reference(x, meta, norm_mix, w_in, na_rpb, mla_q_norm, w_uq, mla_kv_norm, w_ukv,
              w_na_out, w_mla_out, w_out, norm_ffn, w_ff1, w_ff2, norm_final):
    B, S, D = x.shape
    h = jnp.concatenate([jnp.broadcast_to(meta.astype(x.dtype)[None], (B, N_META, D)), x], axis=1)
    L = S + N_META
    pos = jnp.arange(L, dtype=jnp.float32)
    inv_freq = 1.0 / (ROPE_THETA ** (jnp.arange(0, MLA_ROPE_DIM, 2, dtype=jnp.float32) / MLA_ROPE_DIM))
    ang = pos[:, None] * inv_freq[None, :]
    cos, sin = jnp.cos(ang).astype(x.dtype), jnp.sin(ang).astype(x.dtype)

    for l in range(DEPTH):
        hn = rmsnorm(h, norm_mix[l])
        proj = hn @ w_in[l]
        q_na, k_na, v_na, c_q, c_kv, k_rope_raw, g_na, g_mla = jnp.split(proj, IN_SPLITS, axis=-1)
        o_na = neighborhood_attention(
            q_na.reshape(B, L, NA_HEADS, NA_HEAD_DIM),
            k_na.reshape(B, L, NA_HEADS, NA_HEAD_DIM),
            v_na.reshape(B, L, NA_HEADS, NA_HEAD_DIM),
            na_rpb[l]).reshape(B, L, NA_W) @ w_na_out[l]
        o_mla = mla_attention(c_q, c_kv, k_rope_raw, mla_q_norm[l], w_uq[l],
                              mla_kv_norm[l], w_ukv[l], cos, sin) @ w_mla_out[l]
        merged = jax.nn.sigmoid(g_na) * o_na + jax.nn.sigmoid(g_mla) * o_mla
        h = h + merged @ w_out[l]
        fn = rmsnorm(h, norm_ffn[l])
        h = h + jnp.square(jax.nn.relu(fn @ w_ff1[l])) @ w_ff2[l]

    return rmsnorm(h, norm_final)[:, N_META:]
```

```cpp
#include <hip/hip_runtime.h>
#include <hip/hip_cooperative_groups.h>
#include <cstdio>
#include <cstdint>
constexpr int NWAVES = 8;
constexpr int BATCH = 4, SEQ = 4096, DM = 1024, NMETA = 16, M = BATCH * SEQ, KPB = 4224  , LTOT = 4112;
constexpr int D_IN = 4256, N_IN = 4352, FF = 4096;
constexpr float EPS = 1e-6f;
constexpr size_t MiB = 1u << 20;
constexpr size_t WS_ROPE = 0, WS_MP = 786432;
constexpr size_t WS_WIN = 1 * MiB, WS_WUQ = 9 * MiB + 512 * 1024, WS_WUKV = 10 * MiB + 256 * 1024, WS_WNA = 11 * MiB, WS_WMLA = 12 * MiB, WS_WOUT = 13 * MiB, WS_WFF1 = 15 * MiB, WS_WFF2 = 23 * MiB;
constexpr size_t WS_SSQ_CKV = 31 * MiB;
constexpr size_t WS_HN = 32 * MiB, WS_MG = 32 * MiB;
constexpr size_t WS_QNA = 64 * MiB, WS_H2B = 64 * MiB, WS_KNA = 80 * MiB, WS_VNA = 96 * MiB + 512 * 1024, WS_QM = 113 * MiB, WS_KM = 137 * MiB, WS_VM = 162 * MiB;
constexpr size_t WS_GNA = 179 * MiB, WS_GMLA = 211 * MiB, WS_SSQ_CQ = 243 * MiB, WS_SSQ_H2 = 244 * MiB, WS_SSQ_H3 = 245 * MiB, WS_END = 256 * MiB;
constexpr size_t WS_U = 97 * MiB;
constexpr size_t DO_CQ = 0, DO_CKV = 12 * MiB, DO_T = 0, DO_ONA = 32 * MiB, DO_OMLA = 48 * MiB;
static_assert(WS_WIN + (size_t)N_IN * DM * 2 <= WS_WUQ && WS_WUQ + 768 * 384 * 2 <= WS_WUKV && WS_WUKV + 1024 * 256 * 2 <= WS_WNA && WS_WFF2 + (size_t)DM * FF * 2 <= WS_SSQ_CKV, "weights map");
static_assert(WS_SSQ_CKV + (size_t)M * 8 * 4 <= WS_HN && WS_KNA + (size_t)BATCH * KPB * 512 * 2 <= WS_VNA && WS_VNA + (size_t)BATCH * KPB * 512 * 2 <= WS_QM && WS_QM + (size_t)M * 768 * 2 <= WS_KM, "map 1");
static_assert(WS_KM + (size_t)BATCH * KPB * 768 * 2 <= WS_VM && WS_VM + (size_t)BATCH * KPB * 512 * 2 <= WS_GNA && WS_GMLA + (size_t)M * DM * 2 <= WS_SSQ_CQ && WS_SSQ_H3 + (size_t)M * 64 <= WS_END, "map 2");
static_assert(WS_U + (size_t)M * FF * 2 <= WS_SSQ_CQ && WS_H2B + (size_t)M * DM * 2 <= WS_U && WS_MP + 16 * 1312 * 4 <= WS_WIN && (size_t)LTOT * 32 * 4 <= WS_MP && DO_CKV + (size_t)M * 256 * 2 <= DO_ONA, "map 3");
namespace pg8 {
#define PG8_LAS __attribute__((address_space(3)))
typedef unsigned short bf16_t;
typedef short bf16x8 __attribute__((ext_vector_type(8)));
typedef float f32x4 __attribute__((ext_vector_type(4)));
typedef unsigned u32x4 __attribute__((ext_vector_type(4)));
constexpr int BM = 256, BK = 64, HALF = 128, HTB = HALF * BK * 2  , STAGE_BYTES = 8 * HTB, NXCD = 8, WGM = 8;

__host__ __device__ __forceinline__ int lds_byte(int r, int c) { const int st = (r >> 4) * 2 + (c >> 5), rr = r & 15, cc = c & 31, ob = rr * 64 + cc * 2; return st * 1024 + (ob ^ (((ob >> 9) & 1) << 5)); }
__host__ __device__ __forceinline__ void stage_rc(int b, int& R, int& C) { const int st = b / 1024, sb = b % 1024, swz = sb ^ (((sb >> 9) & 1) << 5); R = (st >> 1) * 16 + swz / 64; C = (st & 1) * 32 + (swz % 64) / 2; }
__host__ __device__ __forceinline__ int perm32(int rho) { const int n = rho >> 4, i = rho & 15; return 8 * (i >> 2) + 4 * n + (i & 3); }

struct Unit { int pm, pn, g; };
struct Gemm { const bf16_t* A; const bf16_t* Bt; const bf16_t* A1; const bf16_t* Bt1; int M, N, K; };

struct StaticOrder {
    int nM, nN, nwg, G, c;
    __host__ __device__ void init(int M, int N, int G_, int c_) { nM = M / BM; nN = N / BM; nwg = nM * nN; G = G_; c = c_; }
    __host__ __device__ bool next(int i, Unit& u) const {
        const long L = (long)i * G + c; if (L >= nwg) return false;
        int wgid = (int)L; { const int q = nwg / NXCD, r = nwg % NXCD, xcd = wgid % NXCD, off = wgid / NXCD; wgid = (xcd < r ? xcd * (q + 1) : r * (q + 1) + (xcd - r) * q) + off; }
        const int nig = WGM * nN, gid = wgid / nig, fm = gid * WGM, gsz = (nM - fm) < WGM ? (nM - fm) : WGM;
        u.pm = fm + ((wgid % nig) % gsz); u.pn = (wgid % nig) / gsz; u.g = 0; return true;
    }
    __device__ __forceinline__ void a_ready(const Unit&) const {}
    __device__ __forceinline__ void done(const Unit&) const {}
};

typedef float f32x2 __attribute__((ext_vector_type(2)));
typedef __bf16 bf16x2_cv __attribute__((ext_vector_type(2)));
__device__ __forceinline__ unsigned cvt_pk_bf16(float lo, float hi) { const f32x2 v = {lo, hi}; const bf16x2_cv b = __builtin_convertvector(v, bf16x2_cv); return __builtin_bit_cast(unsigned, b); }
__device__ __forceinline__ u32x4 pack8(const f32x4 a, const f32x4 b) { u32x4 w; w.x = cvt_pk_bf16(a[0], a[1]); w.y = cvt_pk_bf16(a[2], a[3]); w.z = cvt_pk_bf16(b[0], b[1]); w.w = cvt_pk_bf16(b[2], b[3]); return w; }
__device__ __forceinline__ void unpack8(const u32x4 w, f32x4& a, f32x4& b) {
    a[0] = __uint_as_float(w.x << 16); a[1] = __uint_as_float(w.x & 0xffff0000u); a[2] = __uint_as_float(w.y << 16); a[3] = __uint_as_float(w.y & 0xffff0000u);
    b[0] = __uint_as_float(w.z << 16); b[1] = __uint_as_float(w.z & 0xffff0000u); b[2] = __uint_as_float(w.w << 16); b[3] = __uint_as_float(w.w & 0xffff0000u); }
__device__ __forceinline__ float sigm(float x) { return __builtin_amdgcn_rcpf(1.f + __builtin_amdgcn_exp2f(-1.4426950408889634f * x)); }
__device__ __forceinline__ f32x4 sigm4(const f32x4 v) { f32x4 r; r[0] = sigm(v[0]); r[1] = sigm(v[1]); r[2] = sigm(v[2]); r[3] = sigm(v[3]); return r; }
__device__ __forceinline__ float sq4(const f32x4 v) { return (v[0] * v[0] + v[1] * v[1]) + (v[2] * v[2] + v[3] * v[3]); }
__device__ __forceinline__ float red_fq(float s) { s += __shfl_xor(s, 16); s += __shfl_xor(s, 32); return s; }
__device__ __forceinline__ int keyrow(int m) { return (m >> 12) * 4224 + 16 + (m & 4095); }
constexpr float RMS_EPS = 1e-6f;
__device__ __forceinline__ u32x4 rope8(const f32x4 x1, const f32x4 x2, const float* rope, int pos, int fq) {
    const f32x4* t = (const f32x4*)(rope + ((size_t)pos * 16 + 4 * fq) * 2); const f32x4 t0 = t[0], t1 = t[1];
    f32x4 o1, o2;
    o1[0] = x1[0] * t0[0] - x2[0] * t0[1]; o2[0] = x2[0] * t0[0] + x1[0] * t0[1];
    o1[1] = x1[1] * t0[2] - x2[1] * t0[3]; o2[1] = x2[1] * t0[2] + x1[1] * t0[3];
    o1[2] = x1[2] * t1[0] - x2[2] * t1[1]; o2[2] = x2[2] * t1[0] + x1[2] * t1[1];
    o1[3] = x1[3] * t1[2] - x2[3] * t1[3]; o2[3] = x2[3] * t1[2] + x1[3] * t1[3];
    return pack8(o1, o2);
}
#define EPI_ROWS _Pragma("unroll") for (int ai = 0; ai < 2; ++ai) _Pragma("unroll") for (int m = 0; m < 4; ++m)

struct EpiP1 {
    static constexpr bool PERM = true, AFTER_DRAIN = false;
    unsigned char* ws; bf16_t *CKV, *CQ, *KM; float *ssq_ckv, *ssq_cq; const float* rope;
    __device__ __forceinline__ void operator()(const f32x4 (&acc)[2][2][4][2], const Unit& u, int wr, int wc, int fr, int fq) const {
        { int t_ = threadIdx.x; asm volatile("" : "+v"(t_)); fr = t_ & 15; fq = (t_ >> 4) & 3; }
        const int row0 = u.pm * BM + wr * 64 + fr;
#pragma unroll
        for (int bj = 0; bj < 2; ++bj) {
            const int ct = u.pn * 2 + bj, cw = wc * 32 + 8 * fq;
            if (ct < 12) {
                const int which = ct >> 2; bf16_t* base = (bf16_t*)(ws + (which == 0 ? WS_QNA : (which == 1 ? WS_KNA : WS_VNA))); const int col = (ct & 3) * 128 + cw;
                EPI_ROWS { const int row = row0 + ai * HALF + m * 16; const int orow = which == 0 ? row : keyrow(row);
                    *(u32x4*)(base + (size_t)orow * 512 + col) = pack8(acc[ai][bj][m][0], acc[ai][bj][m][1]); }
            } else if (ct < 14) {
                const int col = (ct - 12) * 128 + cw, slot = (ct - 12) * 4 + wc;
                EPI_ROWS { const int row = row0 + ai * HALF + m * 16;
                    *(u32x4*)(CKV + (size_t)row * 256 + col) = pack8(acc[ai][bj][m][0], acc[ai][bj][m][1]);
                    const float s = red_fq(sq4(acc[ai][bj][m][0]) + sq4(acc[ai][bj][m][1])); if (fq == 0) ssq_ckv[(size_t)row * 8 + slot] = s; }
            } else if (ct < 30) {
                bf16_t* base = (bf16_t*)(ws + (ct < 22 ? WS_GNA : WS_GMLA)); const int col = ((ct - 14) & 7) * 128 + cw;
                EPI_ROWS { const int row = row0 + ai * HALF + m * 16;
                    *(u32x4*)(base + (size_t)row * 1024 + col) = pack8(sigm4(acc[ai][bj][m][0]), sigm4(acc[ai][bj][m][1])); }
            } else if (ct < 33) {
                const int col = (ct - 30) * 128 + cw, slot = (ct - 30) * 4 + wc;
                EPI_ROWS { const int row = row0 + ai * HALF + m * 16;
                    *(u32x4*)(CQ + (size_t)row * 384 + col) = pack8(acc[ai][bj][m][0], acc[ai][bj][m][1]);
                    const float s = red_fq(sq4(acc[ai][bj][m][0]) + sq4(acc[ai][bj][m][1])); if (fq == 0) ssq_cq[(size_t)row * 16 + slot] = s; }
            } else if (wc == 0) {
                EPI_ROWS { const int row = row0 + ai * HALF + m * 16; const int pos = 16 + (row & 4095);
                    const u32x4 w = rope8(acc[ai][bj][m][0], acc[ai][bj][m][1], rope, pos, fq);
                    bf16_t* kp = KM + (size_t)keyrow(row) * 768 + 64 + 8 * fq;
#pragma unroll
                    for (int h = 0; h < 8; ++h) *(u32x4*)(kp + h * 96) = w; }
            }
        }
    }
};
struct EpiP2Q {
    static constexpr bool PERM = true, AFTER_DRAIN = false;
    bf16_t* QM; const float* ssq_cq; const float* rope;
    __device__ __forceinline__ void operator()(const f32x4 (&acc)[2][2][4][2], const Unit& u, int wr, int wc, int fr, int fq) const {
        { int t_ = threadIdx.x; asm volatile("" : "+v"(t_)); fr = t_ & 15; fq = (t_ >> 4) & 3; }
        const int row0 = u.pm * BM + wr * 64 + fr;
        EPI_ROWS { const int row = row0 + ai * HALF + m * 16;
            const f32x4* sp = (const f32x4*)(ssq_cq + (size_t)row * 16); const f32x4 s0 = sp[0], s1 = sp[1], s2 = sp[2];
            const float ss = ((s0[0] + s0[1]) + (s0[2] + s0[3])) + ((s1[0] + s1[1]) + (s1[2] + s1[3])) + ((s2[0] + s2[1]) + (s2[2] + s2[3]));
            const float rstd = 1.0f / sqrtf(ss * (1.0f / 384.0f) + RMS_EPS);
#pragma unroll
            for (int bj = 0; bj < 2; ++bj) {
                const f32x4 v0 = acc[ai][bj][m][0] * rstd, v1 = acc[ai][bj][m][1] * rstd;
                if (u.pn < 2) { const int c = u.pn * 256 + bj * HALF + wc * 32 + 8 * fq; const int h = c >> 6, d = c & 63;
                    *(u32x4*)(QM + (size_t)row * 768 + h * 96 + d) = pack8(v0, v1); }
                else { const int h = bj * 4 + wc; const int pos = 16 + (row & 4095);
                    *(u32x4*)(QM + (size_t)row * 768 + h * 96 + 64 + 8 * fq) = rope8(v0, v1, rope, pos, fq); }
            } asm volatile("" ::: "memory"); }
    }
};
struct EpiP2KV {
    static constexpr bool PERM = true, AFTER_DRAIN = false;
    bf16_t *KM, *VM; const float* ssq_ckv;
    __device__ __forceinline__ void operator()(const f32x4 (&acc)[2][2][4][2], const Unit& u, int wr, int wc, int fr, int fq) const {
        { int t_ = threadIdx.x; asm volatile("" : "+v"(t_)); fr = t_ & 15; fq = (t_ >> 4) & 3; }
        const int row0 = u.pm * BM + wr * 64 + fr;
        EPI_ROWS { const int row = row0 + ai * HALF + m * 16; const size_t kr = (size_t)keyrow(row);
            const f32x4* sp = (const f32x4*)(ssq_ckv + (size_t)row * 8); const f32x4 s0 = sp[0], s1 = sp[1];
            const float ss = ((s0[0] + s0[1]) + (s0[2] + s0[3])) + ((s1[0] + s1[1]) + (s1[2] + s1[3]));
            const float rstd = 1.0f / sqrtf(ss * (1.0f / 256.0f) + RMS_EPS);
#pragma unroll
            for (int bj = 0; bj < 2; ++bj) {
                const f32x4 v0 = acc[ai][bj][m][0] * rstd, v1 = acc[ai][bj][m][1] * rstd;
                const int c = (u.pn & 1) * 256 + bj * HALF + wc * 32 + 8 * fq;
                if (u.pn < 2) { const int h = c >> 6, d = c & 63; *(u32x4*)(KM + kr * 768 + h * 96 + d) = pack8(v0, v1); }
                else *(u32x4*)(VM + kr * 512 + c) = pack8(v0, v1);
            } asm volatile("" ::: "memory"); }
    }
};
struct EpiP4 {
    static constexpr bool PERM = true, AFTER_DRAIN = false;
    unsigned char* ws; bf16_t* T; bf16_t* MG; int g;
    __device__ __forceinline__ void operator()(const f32x4 (&acc)[2][2][4][2], const Unit& u, int wr, int wc, int fr, int fq) const {
        { int t_ = threadIdx.x; asm volatile("" : "+v"(t_)); fr = t_ & 15; fq = (t_ >> 4) & 3; }
        const int row0 = u.pm * BM + wr * 64 + fr, col0 = u.pn * BM + wc * 32 + 8 * fq;
        EPI_ROWS { const int row = row0 + ai * HALF + m * 16;
#pragma unroll
            for (int bj = 0; bj < 2; ++bj) { const size_t off = (size_t)row * 1024 + col0 + bj * HALF;
                f32x4 g0, g1; unpack8(*(const u32x4*)((const bf16_t*)(ws + (g ? WS_GMLA : WS_GNA)) + off), g0, g1);
                const f32x4 v0 = acc[ai][bj][m][0] * g0, v1 = acc[ai][bj][m][1] * g1;
                if (g == 0) *(u32x4*)(T + off) = pack8(v0, v1);
                else { f32x4 t0, t1; unpack8(*(const u32x4*)(T + off), t0, t1); *(u32x4*)(MG + off) = pack8(t0 + v0, t1 + v1); }
            } asm volatile("" ::: "memory"); }
    }
};
struct EpiP5 {
    static constexpr bool PERM = true, AFTER_DRAIN = false;
    const float* X; float* H2; bf16_t* H2B; float* ssq;
    __device__ __forceinline__ void operator()(const f32x4 (&acc)[2][2][4][2], const Unit& u, int wr, int wc, int fr, int fq) const {
        { int t_ = threadIdx.x; asm volatile("" : "+v"(t_)); fr = t_ & 15; fq = (t_ >> 4) & 3; }
        const int row0 = u.pm * BM + wr * 64 + fr, col0 = u.pn * BM + wc * 32 + 8 * fq;
        EPI_ROWS { const int row = row0 + ai * HALF + m * 16; float s = 0.f;
#pragma unroll
            for (int bj = 0; bj < 2; ++bj) { const size_t off = (size_t)row * 1024 + col0 + bj * HALF;
                const f32x4 v0 = *(const f32x4*)(X + off) + acc[ai][bj][m][0], v1 = *(const f32x4*)(X + off + 4) + acc[ai][bj][m][1];
                *(f32x4*)(H2 + off) = v0; *(f32x4*)(H2 + off + 4) = v1; *(u32x4*)(H2B + off) = pack8(v0, v1); s += sq4(v0) + sq4(v1); }
            s = red_fq(s); if (fq == 0) ssq[(size_t)row * 16 + u.pn * 4 + wc] = s; asm volatile("" ::: "memory"); }
    }
};
__device__ __forceinline__ float sum16(const float* p) { const f32x4* q = (const f32x4*)p; const f32x4 a = q[0], b = q[1], c = q[2], d = q[3];
    return (((a[0] + a[1]) + (a[2] + a[3])) + ((b[0] + b[1]) + (b[2] + b[3]))) + (((c[0] + c[1]) + (c[2] + c[3])) + ((d[0] + d[1]) + (d[2] + d[3]))); }
struct EpiP6 {
    static constexpr bool PERM = true, AFTER_DRAIN = false;
    bf16_t* U; const float* ssq;
    __device__ __forceinline__ void operator()(const f32x4 (&acc)[2][2][4][2], const Unit& u, int wr, int wc, int fr, int fq) const {
        { int t_ = threadIdx.x; asm volatile("" : "+v"(t_)); fr = t_ & 15; fq = (t_ >> 4) & 3; }
        const int row0 = u.pm * BM + wr * 64 + fr, col0 = u.pn * BM + wc * 32 + 8 * fq;
        EPI_ROWS { const int row = row0 + ai * HALF + m * 16;
            const float rstd = 1.0f / sqrtf(sum16(ssq + (size_t)row * 16) * (1.0f / 1024.0f) + RMS_EPS);
#pragma unroll
            for (int bj = 0; bj < 2; ++bj) { const size_t off = (size_t)row * 4096 + col0 + bj * HALF;
                f32x4 v0 = acc[ai][bj][m][0] * rstd, v1 = acc[ai][bj][m][1] * rstd;
#pragma unroll
                for (int e = 0; e < 4; ++e) { const float a = fmaxf(v0[e], 0.f), b = fmaxf(v1[e], 0.f); v0[e] = a * a; v1[e] = b * b; }
                *(u32x4*)(U + off) = pack8(v0, v1); } asm volatile("" ::: "memory"); }
    }
};
struct EpiP7 {
    static constexpr bool PERM = true, AFTER_DRAIN = false;
    float* H; float* ssq;
    __device__ __forceinline__ void operator()(const f32x4 (&acc)[2][2][4][2], const Unit& u, int wr, int wc, int fr, int fq) const {
        { int t_ = threadIdx.x; asm volatile("" : "+v"(t_)); fr = t_ & 15; fq = (t_ >> 4) & 3; }
        const int row0 = u.pm * BM + wr * 64 + fr, col0 = u.pn * BM + wc * 32 + 8 * fq;
        EPI_ROWS { const int row = row0 + ai * HALF + m * 16; float s = 0.f;
#pragma unroll
            for (int bj = 0; bj < 2; ++bj) { const size_t off = (size_t)row * 1024 + col0 + bj * HALF;
                const f32x4 v0 = *(const f32x4*)(H + off) + acc[ai][bj][m][0], v1 = *(const f32x4*)(H + off + 4) + acc[ai][bj][m][1];
                *(f32x4*)(H + off) = v0; *(f32x4*)(H + off + 4) = v1; s += sq4(v0) + sq4(v1); }
            s = red_fq(s); if (fq == 0) ssq[(size_t)row * 16 + u.pn * 4 + wc] = s; asm volatile("" ::: "memory"); }
    }
};
struct PairOrder {
    StaticOrder so;
    __device__ __forceinline__ bool next(int i, Unit& u) const { if (!so.next(i >> 1, u)) return false; u.g = i & 1; return true; }
    __device__ __forceinline__ void a_ready(const Unit&) const {}
    __device__ __forceinline__ void done(const Unit&) const {}
};

template <class Epi, class Sched, bool ALIGN_EPI = false, bool SP2 = false>
__device__ __forceinline__ void gemm_phase(PG8_LAS unsigned char* lds, const Gemm g, const Sched& S, const Epi& E) {
    int tid_ = threadIdx.x; asm volatile("" : "+v"(tid_));
    const int tid = tid_, wid = __builtin_amdgcn_readfirstlane(tid >> 6), lane = tid & 63, wr = wid >> 2, wc = wid & 3, fr = lane & 15, fq = lane >> 4;
    int K_ = g.K; asm volatile("" : "+s"(K_));
    const int K = K_, nt = K / BK;
    unsigned voffA[2], voffB[2];
#pragma unroll
    for (int i = 0; i < 2; ++i) { int R, C; stage_rc(tid * 16 + i * 8192, R, C); const int Rb = Epi::PERM ? ((R & ~31) + perm32(R & 31)) : R;
        voffA[i] = (unsigned)(R * K + C) * 2u; voffB[i] = (unsigned)(Rb * K + C) * 2u; }
    const size_t kstep = (size_t)(BK * 2);
    const size_t hstep = (size_t)HALF * K * 2;
    const size_t tstep = 2 * hstep;
    const unsigned ldsw = (unsigned)wid * 1024u;
    const int aoff = lds_byte(wr * 64 + fr, fq * 8), boff = lds_byte(wc * 32 + fr, fq * 8);
#define PG8_SA(b, h) (((b) * 2 + (h)) * HTB)
#define PG8_SB(b, h) ((4 + (b) * 2 + (h)) * HTB)
#define PG8_STAGE(bufoff, gbase, voff) do { _Pragma("unroll") for (int _i = 0; _i < 2; ++_i) \
        __builtin_amdgcn_global_load_lds((const unsigned*)((const char*)(gbase) + (voff)[_i]), (PG8_LAS unsigned*)(lds + (bufoff) + ldsw + _i * 8192), 16, 0, 0); } while (0)
#define PG8_LDA(dst, b, h) do { _Pragma("unroll") for (int m = 0; m < 4; ++m) _Pragma("unroll") for (int k = 0; k < 2; ++k) dst[m][k] = *(const PG8_LAS bf16x8*)(lds + PG8_SA(b, h) + aoff + m * 2048 + k * 1024); } while (0)
#define PG8_LDB(dst, b, h) do { _Pragma("unroll") for (int n = 0; n < 2; ++n) _Pragma("unroll") for (int k = 0; k < 2; ++k) dst[n][k] = *(const PG8_LAS bf16x8*)(lds + PG8_SB(b, h) + boff + n * 2048 + k * 1024); } while (0)
#define PG8_MMA(ai, bj, At, Bt) do { __builtin_amdgcn_s_setprio(1); _Pragma("unroll") for (int m = 0; m < 4; ++m) _Pragma("unroll") for (int n = 0; n < 2; ++n) _Pragma("unroll") for (int k = 0; k < 2; ++k) \
        acc[ai][bj][m][n] = __builtin_amdgcn_mfma_f32_16x16x32_bf16(Bt[n][k], At[m][k], acc[ai][bj][m][n], 0, 0, 0); __builtin_amdgcn_s_setprio(0); } while (0)
#define PG8_WAIT_V(n) asm volatile("s_waitcnt vmcnt(" #n ")" ::: "memory")
#define PG8_WAIT_L(n) asm volatile("s_waitcnt lgkmcnt(" #n ")" ::: "memory")
#define PG8_BAR __builtin_amdgcn_s_barrier()
#define PG8_SCHED __builtin_amdgcn_sched_barrier(0)
    Unit cur, nxt; int ui = 0;
    if (!S.next(0, cur)) return;
    f32x4 acc[2][2][4][2];
#pragma unroll
    for (int a = 0; a < 2; ++a)
#pragma unroll
        for (int b = 0; b < 2; ++b)
#pragma unroll
            for (int m = 0; m < 4; ++m)
#pragma unroll
                for (int n = 0; n < 2; ++n) acc[a][b][m][n] = (f32x4){0.f, 0.f, 0.f, 0.f};
    bf16x8 At[4][2], B0[2][2], B1[2][2];
    const char* cA = (const char*)(cur.g ? g.A1 : g.A) + (size_t)cur.pm * tstep; const char* cB = (const char*)(cur.g ? g.Bt1 : g.Bt) + (size_t)cur.pn * tstep;
    S.a_ready(cur);
    if constexpr (SP2) {
        PG8_STAGE(PG8_SB(0, 0), cB, voffB); PG8_STAGE(PG8_SB(0, 1), cB + hstep, voffB); PG8_STAGE(PG8_SA(0, 0), cA, voffA); PG8_STAGE(PG8_SA(0, 1), cA + hstep, voffA);
        if (wr == 1) PG8_BAR;
        PG8_WAIT_V(2); PG8_BAR;
        PG8_STAGE(PG8_SB(1, 0), cB + kstep, voffB); PG8_STAGE(PG8_SA(1, 0), cA + kstep, voffA); PG8_STAGE(PG8_SB(1, 1), cB + hstep + kstep, voffB);
        PG8_WAIT_V(6); PG8_BAR;
    } else {
        PG8_STAGE(PG8_SB(0, 0), cB, voffB); PG8_STAGE(PG8_SA(0, 0), cA, voffA); PG8_STAGE(PG8_SB(0, 1), cB + hstep, voffB); PG8_STAGE(PG8_SA(0, 1), cA + hstep, voffA);
        if (wr == 1) PG8_BAR;
        PG8_WAIT_V(4); PG8_BAR;
        PG8_STAGE(PG8_SB(1, 0), cB + kstep, voffB); PG8_STAGE(PG8_SA(1, 0), cA + kstep, voffA); PG8_STAGE(PG8_SB(1, 1), cB + hstep + kstep, voffB);
        PG8_WAIT_V(6); PG8_BAR;
    }
    for (;;) {
        const bool has_next = S.next(ui + 1, nxt);
        const char* nA = has_next ? (const char*)(nxt.g ? g.A1 : g.A) + (size_t)nxt.pm * tstep : cA; const char* nB = has_next ? (const char*)(nxt.g ? g.Bt1 : g.Bt) + (size_t)nxt.pn * tstep : cB;
        for (int t = 0; t < nt; t += 2) {
            const bool last = (t == nt - 2);
            const char* a1 = cA + (size_t)(t + 1) * kstep;
            const char* a2 = last ? nA : cA + (size_t)(t + 2) * kstep; const char* b2 = last ? nB : cB + (size_t)(t + 2) * kstep;
            const char* a3 = a2 + kstep; const char* b3 = b2 + kstep;
            if (last && has_next) S.a_ready(nxt);
            if constexpr (SP2) {
            PG8_LDB(B0, 0, 0); PG8_LDB(B1, 0, 1); PG8_SCHED; PG8_LDA(At, 0, 0); PG8_STAGE(PG8_SA(1, 1), a1 + hstep, voffA);
            PG8_WAIT_V(8); PG8_WAIT_L(0); PG8_BAR; PG8_MMA(0, 0, At, B0); PG8_MMA(0, 1, At, B1); PG8_BAR; PG8_SCHED;
            PG8_LDA(At, 0, 1); PG8_STAGE(PG8_SB(0, 0), b2, voffB); PG8_STAGE(PG8_SB(0, 1), b2 + hstep, voffB); PG8_STAGE(PG8_SA(0, 0), a2, voffA);
            PG8_WAIT_V(8); PG8_WAIT_L(0); PG8_BAR; PG8_MMA(1, 0, At, B0); PG8_MMA(1, 1, At, B1); PG8_BAR; PG8_SCHED;
            PG8_LDB(B0, 1, 0); PG8_LDB(B1, 1, 1); PG8_SCHED; PG8_LDA(At, 1, 0); PG8_STAGE(PG8_SA(0, 1), a2 + hstep, voffA);
            PG8_WAIT_V(8); PG8_WAIT_L(0); PG8_BAR; PG8_MMA(0, 0, At, B0); PG8_MMA(0, 1, At, B1); PG8_BAR; PG8_SCHED;
            PG8_LDA(At, 1, 1); PG8_STAGE(PG8_SB(1, 0), b3, voffB); PG8_STAGE(PG8_SB(1, 1), b3 + hstep, voffB); PG8_STAGE(PG8_SA(1, 0), a3, voffA);
            PG8_WAIT_V(8); PG8_WAIT_L(0); PG8_BAR; PG8_MMA(1, 0, At, B0); PG8_MMA(1, 1, At, B1); PG8_BAR; PG8_SCHED;
            } else {
            PG8_LDB(B0, 0, 0); PG8_SCHED; PG8_LDA(At, 0, 0); PG8_STAGE(PG8_SA(1, 1), a1 + hstep, voffA);
            PG8_WAIT_L(8); PG8_BAR; PG8_WAIT_L(0); PG8_MMA(0, 0, At, B0); PG8_BAR; PG8_SCHED;
            PG8_LDB(B1, 0, 1); PG8_STAGE(PG8_SB(0, 0), b2, voffB);
            PG8_BAR; PG8_WAIT_L(0); PG8_MMA(0, 1, At, B1); PG8_BAR;
            PG8_LDA(At, 0, 1); PG8_STAGE(PG8_SA(0, 0), a2, voffA);
            PG8_BAR; PG8_WAIT_L(0); PG8_MMA(1, 0, At, B0); PG8_BAR; PG8_SCHED;
            PG8_STAGE(PG8_SB(0, 1), b2 + hstep, voffB);
            PG8_WAIT_V(6); PG8_BAR; PG8_MMA(1, 1, At, B1); PG8_BAR;
            PG8_LDB(B0, 1, 0); PG8_SCHED; PG8_LDA(At, 1, 0); PG8_STAGE(PG8_SA(0, 1), a2 + hstep, voffA);
            PG8_WAIT_L(8); PG8_BAR; PG8_WAIT_L(0); PG8_MMA(0, 0, At, B0); PG8_BAR; PG8_SCHED;
            PG8_LDB(B1, 1, 1); PG8_STAGE(PG8_SB(1, 0), b3, voffB);
            PG8_BAR; PG8_WAIT_L(0); PG8_MMA(0, 1, At, B1); PG8_BAR;
            PG8_LDA(At, 1, 1); PG8_STAGE(PG8_SA(1, 0), a3, voffA);
            PG8_BAR; PG8_WAIT_L(0); PG8_MMA(1, 0, At, B0); PG8_BAR; PG8_SCHED;
            PG8_STAGE(PG8_SB(1, 1), b3 + hstep, voffB);
            PG8_WAIT_V(6); PG8_BAR; PG8_MMA(1, 1, At, B1); PG8_BAR;
            }
        }
        if constexpr (ALIGN_EPI) { if (wr == 0) PG8_BAR; }
        if constexpr (!Epi::AFTER_DRAIN) { E(acc, cur, wr, wc, fr, fq); S.done(cur); }
        if (!has_next) break;
#pragma unroll
        for (int a = 0; a < 2; ++a)
#pragma unroll
            for (int b = 0; b < 2; ++b)
#pragma unroll
                for (int m = 0; m < 4; ++m)
#pragma unroll
                    for (int n = 0; n < 2; ++n) acc[a][b][m][n] = (f32x4){0.f, 0.f, 0.f, 0.f};
        cur = nxt; cA = nA; cB = nB; ++ui;
        if constexpr (ALIGN_EPI) { if (wr == 1) PG8_BAR; }
    }
    PG8_WAIT_V(0);
    if constexpr (!ALIGN_EPI) { if (wr == 0) PG8_BAR; }
    PG8_BAR;
    if constexpr (Epi::AFTER_DRAIN) { E.fused(acc, cur, wr, wc, fr, fq, lds, wid, lane); S.done(cur); }
#undef PG8_SA
#undef PG8_SB
#undef PG8_STAGE
#undef PG8_LDA
#undef PG8_LDB
#undef PG8_MMA
#undef PG8_WAIT_V
#undef PG8_WAIT_L
#undef PG8_BAR
#undef PG8_SCHED
}
}
namespace att {
typedef unsigned short bf16_t;
using bf16x8 = __attribute__((ext_vector_type(8))) short;
using s16x4  = __attribute__((ext_vector_type(4))) short;
using f32x16 = __attribute__((ext_vector_type(16))) float;
using u32x4  = __attribute__((ext_vector_type(4))) unsigned;
#define KSWZ(row, colB) ((row) * 256 + ((colB) ^ (((row) & 7) << 4)))
#define SBAR() __builtin_amdgcn_sched_barrier(0)
constexpr float NEGV = -1e30f, THR = 8.f;
__device__ __forceinline__ int crow(int r, int hi) { return (r & 3) + 8 * (r >> 2) + 4 * hi; }
typedef float f32x2_cv __attribute__((ext_vector_type(2))); typedef __bf16 bf16x2_cv __attribute__((ext_vector_type(2)));
__device__ __forceinline__ unsigned cvtpk(float lo, float hi) { const f32x2_cv v = {lo, hi}; const bf16x2_cv b = __builtin_convertvector(v, bf16x2_cv); return __builtin_bit_cast(unsigned, b); }
template <int DQK> struct Cfg { static constexpr float SCALE = (DQK == 96) ? 0.10206207261596577f : 0.125f; };

template <int DQK> __device__ __forceinline__ void partialSM(f32x16& p0, f32x16& p1, float& m_reg, float& mn, float& alpha) {
  constexpr float SCALE = Cfg<DQK>::SCALE, C = SCALE * 1.4426950408889634f;
  float pmax = p0[0];
#pragma unroll
  for (int r = 1; r < 16; ++r) pmax = fmaxf(pmax, p0[r]);
#pragma unroll
  for (int r = 0; r < 16; ++r) pmax = fmaxf(pmax, p1[r]);
  { auto rr = __builtin_amdgcn_permlane32_swap(__float_as_uint(pmax), __float_as_uint(pmax), false, false);
    pmax = fmaxf(__uint_as_float(rr[0]), __uint_as_float(rr[1])); }
  if (__builtin_expect(__all(pmax - m_reg <= THR / SCALE), 1)) { mn = m_reg; alpha = 1.f; }
  else { mn = fmaxf(m_reg, pmax); alpha = __builtin_amdgcn_exp2f((m_reg - mn) * C); m_reg = mn; }
  const float mnC = -mn * C;
#pragma unroll
  for (int r = 0; r < 16; ++r) p0[r] = fmaf(p0[r], C, mnC);
#pragma unroll
  for (int r = 0; r < 16; ++r) p1[r] = fmaf(p1[r], C, mnC);
#pragma unroll
  for (int r = 0; r < 16; ++r) p0[r] = __builtin_amdgcn_exp2f(p0[r]);
}
__device__ __forceinline__ void finishSM(f32x16& p0, f32x16& p1, float alpha, float& l_reg, bf16x8& pa0, bf16x8& pa1, bf16x8& pa2, bf16x8& pa3) {
#pragma unroll
  for (int r = 0; r < 16; ++r) p1[r] = __builtin_amdgcn_exp2f(p1[r]);
  float ps = 0;
#pragma unroll
  for (int r = 0; r < 16; ++r) ps += p0[r];
#pragma unroll
  for (int r = 0; r < 16; ++r) ps += p1[r];
  { auto rr = __builtin_amdgcn_permlane32_swap(__float_as_uint(ps), __float_as_uint(ps), false, false);
    ps = __uint_as_float(rr[0]) + __uint_as_float(rr[1]); }
  l_reg = l_reg * alpha + ps;
#define PK4(P, BASE, OUT) do { unsigned a0 = cvtpk(P[BASE + 0], P[BASE + 1]), a1 = cvtpk(P[BASE + 2], P[BASE + 3]);   \
    unsigned b0 = cvtpk(P[BASE + 4], P[BASE + 5]), b1 = cvtpk(P[BASE + 6], P[BASE + 7]);                              \
    auto r0 = __builtin_amdgcn_permlane32_swap(a0, b0, false, false); auto r1 = __builtin_amdgcn_permlane32_swap(a1, b1, false, false); \
    u32x4 w = {r0[0], r1[0], r0[1], r1[1]}; OUT = *reinterpret_cast<bf16x8*>(&w); } while (0)
  PK4(p0, 0, pa0); PK4(p0, 8, pa1); PK4(p1, 0, pa2); PK4(p1, 8, pa3);
#undef PK4
}
template <int DQK> __device__ __forceinline__ void qkt(f32x16& p0, f32x16& p1, const char* Ks, const bf16x8* qr, int r32, int hi) {
  p0 = f32x16{}; p1 = f32x16{};
#pragma unroll
  for (int d0 = 0; d0 < DQK / 16; ++d0) { const int cb = (d0 * 16 + hi * 8) * 2;
    const bf16x8 b0 = *reinterpret_cast<const bf16x8*>(Ks + KSWZ(r32, cb));
    const bf16x8 b1 = *reinterpret_cast<const bf16x8*>(Ks + KSWZ(32 + r32, cb));
    p0 = __builtin_amdgcn_mfma_f32_32x32x16_bf16(b0, qr[d0], p0, 0, 0, 0);
    p1 = __builtin_amdgcn_mfma_f32_32x32x16_bf16(b1, qr[d0], p1, 0, 0, 0); }
}
__device__ __forceinline__ int v_st(int k, int c) { const int kk = (k & ~0xC) | ((k & 4) << 1) | ((k & 8) >> 1); return ((kk >> 3) * 4 + (c >> 5)) * 512 + ((kk & 7) * 32 + (c & 31)) * 2; }
__device__ __forceinline__ int v_rd_base(int lane) { return ((lane & 3) << 3) | (((lane >> 2) & 3) << 6) | (((lane >> 4) & 1) << 5) | (((lane >> 5) & 1) << 8); }
constexpr int v_rd_off(int d0, int ks, int half) { return d0 * 512 + ks * 4096 + half * 2048; }
template <int OFF> __device__ __forceinline__ s16x4 tr_read(int vb) {
  s16x4 r; asm volatile("ds_read_b64_tr_b16 %0, %1 offset:%2" : "=&v"(r) : "v"(vb), "i"(OFF) : "memory"); return r;
}
template <int D0> __device__ __forceinline__ void pv_one(f32x16& od, int vb, bf16x8 pa0, bf16x8 pa1, bf16x8 pa2, bf16x8 pa3) {
  const s16x4 l0 = tr_read<v_rd_off(D0, 0, 0)>(vb), h0 = tr_read<v_rd_off(D0, 0, 1)>(vb), l1 = tr_read<v_rd_off(D0, 1, 0)>(vb), h1 = tr_read<v_rd_off(D0, 1, 1)>(vb);
  const s16x4 l2 = tr_read<v_rd_off(D0, 2, 0)>(vb), h2 = tr_read<v_rd_off(D0, 2, 1)>(vb), l3 = tr_read<v_rd_off(D0, 3, 0)>(vb), h3 = tr_read<v_rd_off(D0, 3, 1)>(vb);
  asm volatile("s_waitcnt lgkmcnt(0)" ::: "memory"); SBAR();
#define PK(L, H) (bf16x8){L[0], L[1], L[2], L[3], H[0], H[1], H[2], H[3]}
  od = __builtin_amdgcn_mfma_f32_32x32x16_bf16(pa0, PK(l0, h0), od, 0, 0, 0);
  od = __builtin_amdgcn_mfma_f32_32x32x16_bf16(pa1, PK(l1, h1), od, 0, 0, 0);
  od = __builtin_amdgcn_mfma_f32_32x32x16_bf16(pa2, PK(l2, h2), od, 0, 0, 0);
  od = __builtin_amdgcn_mfma_f32_32x32x16_bf16(pa3, PK(l3, h3), od, 0, 0, 0);
#undef PK
}
__device__ __forceinline__ void pv2(f32x16* o, int vb, bf16x8 pa0, bf16x8 pa1, bf16x8 pa2, bf16x8 pa3) {
  pv_one<0>(o[0], vb, pa0, pa1, pa2, pa3); pv_one<1>(o[1], vb, pa0, pa1, pa2, pa3);
}

template <int DQK, bool IS_NA>
__device__ __forceinline__ void attn_unit(const bf16_t* __restrict__ Qb, const bf16_t* __restrict__ Kh, const bf16_t* __restrict__ Vh, bf16_t* Ob,
                                          const int NT, const int r0, const int krow0, const int nkr, const float* __restrict__ rpbh, char* lds) {
  constexpr int LDQ = IS_NA ? 512 : 768, LDK = LDQ, LDV = 512, LDO = 512, ND = DQK / 16, NKC = DQK / 8;
  constexpr bool K2 = (NKC * 64 > 512);
  int tid_ = threadIdx.x; asm volatile("" : "+v"(tid_));
  const int tid = tid_, wid = __builtin_amdgcn_readfirstlane(tid >> 6), lane = tid & 63, r32 = lane & 31, hi = lane >> 5;
  char* V_lds = lds; char* K_lds = lds + 32768;
  float* ws = (float*)(lds + 65536) + wid * 64; float* li_l = ws; float* al_l = ws + 32;
  float* tab = (float*)(lds + 65536 + 2048);
  if constexpr (IS_NA) { for (int i = tid; i < 15 * 128; i += 512) { const int dr = i >> 7, x = (i & 127) - 48; tab[i] = (x >= 0 && x < 31) ? rpbh[dr * 31 + x] * 8.f : 0.f; } }
  const int myrow = r0 + (wid >> 1), rs = min(max(myrow - 4, 0), 56), cq = (wid & 1) * 32 + r32, lo = min(max(cq - 8, 0), 48);
  float m_reg = -1e30f, l_reg = 0; f32x16 o[2]; o[0] = f32x16{}; o[1] = f32x16{}; bf16x8 qr[ND];
  const bf16_t* Qw = Qb + (size_t)(wid * 32 + r32) * LDQ + hi * 8;
#pragma unroll
  for (int d0 = 0; d0 < ND; ++d0) qr[d0] = *reinterpret_cast<const bf16x8*>(Qw + d0 * 16);
  const int kr0 = tid / NKC, kc0 = tid % NKC;
  const int ck1 = (tid + 512 < NKC * 64) ? tid + 512 : NKC * 64 - 1; const int kr1 = ck1 / NKC, kc1 = ck1 % NKC; const bool k1on = (tid + 512) < NKC * 64;
  const int vr = tid >> 3, vc = (tid & 7) * 8;
  const int vst = v_st(vr, vc), kst0 = KSWZ(kr0, kc0 * 16), kst1 = KSWZ(kr1, kc1 * 16);
  const int vb0 = (int)(uintptr_t)V_lds + v_rd_base(lane);
  struct { bf16x8 vs0, ks0, ks1; } sr_[2];
#define KEYBASE(j) (IS_NA ? ((j) == 0 ? 0 : 16 + 64 * min(krow0 + (j) - 1, krow0 + nkr - 1)) : 64 * (j))
#define SLOAD(i, j) do { const int kb_ = KEYBASE(j); sr_[i].ks0 = *reinterpret_cast<const bf16x8*>(Kh + (size_t)(kb_ + kr0) * LDK + kc0 * 8); \
    if (K2) sr_[i].ks1 = *reinterpret_cast<const bf16x8*>(Kh + (size_t)(kb_ + kr1) * LDK + kc1 * 8); \
    sr_[i].vs0 = *reinterpret_cast<const bf16x8*>(Vh + (size_t)(kb_ + vr) * LDV + vc); } while (0)
#define SWRITE(b, i) do { *(bf16x8*)(K_lds + (b) * 16384 + kst0) = sr_[i].ks0; if (K2 && k1on) *(bf16x8*)(K_lds + (b) * 16384 + kst1) = sr_[i].ks1; \
    *(bf16x8*)(V_lds + (b) * 16384 + vst) = sr_[i].vs0; } while (0)
#define SWAIT() do { if (K2) asm volatile("s_waitcnt vmcnt(3)" ::: "memory"); else asm volatile("s_waitcnt vmcnt(2)" ::: "memory"); } while (0)
#define RESC(a) do { if (__any((a) < 1.f)) { if (hi == 0) al_l[r32] = (a); asm volatile("s_waitcnt lgkmcnt(0)" ::: "memory"); \
    _Pragma("unroll") for (int d = 0; d < 2; ++d) _Pragma("unroll") for (int r = 0; r < 16; ++r) o[d][r] *= al_l[crow(r, hi)]; } } while (0)
#define MASK(P0, P1, j) do { \
    if (!IS_NA) { if ((j) >= 64) { const int kb_ = 64 * (j) + 4 * hi; \
        _Pragma("unroll") for (int r = 0; r < 16; ++r) { const int kv = kb_ + (r & 3) + 8 * (r >> 2); if (kv >= 4112) P0[r] = NEGV; if (kv + 32 >= 4112) P1[r] = NEGV; } } } \
    else if ((j) == 0) { _Pragma("unroll") for (int r = 0; r < 16; ++r) { const int kc = (r & 3) + 8 * (r >> 2) + 4 * hi; if (kc >= 16) P0[r] = NEGV; P1[r] = NEGV; } } \
    else { const int kr_ = krow0 + (j) - 1; const bool ok_ = ((j) - 1 < nkr) && (kr_ >= rs) && (kr_ < rs + 8); \
      if (!ok_) { _Pragma("unroll") for (int r = 0; r < 16; ++r) { P0[r] = NEGV; P1[r] = NEGV; } } \
      else { const float* tb_ = tab + (kr_ - myrow + 7) * 128 + (63 - cq) + 4 * hi; const int kl_ = 4 * hi - lo; \
        _Pragma("unroll") for (int r = 0; r < 16; ++r) { const int e = (r & 3) + 8 * (r >> 2); const float b0 = tb_[e], b1 = tb_[e + 32]; \
          P0[r] = ((unsigned)(e + kl_) < 16u) ? P0[r] + b0 : NEGV; P1[r] = ((unsigned)(e + 32 + kl_) < 16u) ? P1[r] + b1 : NEGV; } } } \
  } while (0)
  f32x16 pA0, pA1, pB0, pB1; float mnA, mnB, alA, alB; bf16x8 pa0, pa1, pa2, pa3;
  constexpr int SE = 0, SO = 1;
  SLOAD(SE, 0); asm volatile("s_waitcnt vmcnt(0)" ::: "memory"); SWRITE(0, SE); __syncthreads();
  qkt<DQK>(pA0, pA1, K_lds, qr, r32, hi); MASK(pA0, pA1, 0); partialSM<DQK>(pA0, pA1, m_reg, mnA, alA);
  SLOAD(SO, 1); if (2 < NT) SLOAD(SE, 2);
  SWAIT(); SWRITE(1, SO); __syncthreads();
  for (int j = 1; j + 1 < NT; j += 2) {
    SBAR(); qkt<DQK>(pB0, pB1, K_lds + 16384, qr, r32, hi);
    finishSM(pA0, pA1, alA, l_reg, pa0, pa1, pa2, pa3); SBAR();
    SLOAD(SO, j + 2); SBAR();
    pv2(o, vb0, pa0, pa1, pa2, pa3); MASK(pB0, pB1, j); partialSM<DQK>(pB0, pB1, m_reg, mnB, alB);
    __syncthreads(); SWAIT(); SWRITE(0, SE);
    RESC(alB); __syncthreads();
    SBAR(); qkt<DQK>(pA0, pA1, K_lds, qr, r32, hi);
    finishSM(pB0, pB1, alB, l_reg, pa0, pa1, pa2, pa3); SBAR();
    if (j + 3 < NT) SLOAD(SE, j + 3); SBAR();
    pv2(o, vb0 + 16384, pa0, pa1, pa2, pa3); MASK(pA0, pA1, j + 1); partialSM<DQK>(pA0, pA1, m_reg, mnA, alA);
    __syncthreads(); SWAIT(); SWRITE(1, SO);
    RESC(alA); __syncthreads();
  }
  SBAR(); qkt<DQK>(pB0, pB1, K_lds + 16384, qr, r32, hi);
  finishSM(pA0, pA1, alA, l_reg, pa0, pa1, pa2, pa3); SBAR();
  pv2(o, vb0, pa0, pa1, pa2, pa3); MASK(pB0, pB1, NT - 1); partialSM<DQK>(pB0, pB1, m_reg, mnB, alB);
  __syncthreads(); RESC(alB);
  finishSM(pB0, pB1, alB, l_reg, pa0, pa1, pa2, pa3); SBAR();
  pv2(o, vb0 + 16384, pa0, pa1, pa2, pa3);
  if (hi == 0) li_l[r32] = l_reg; asm volatile("s_waitcnt lgkmcnt(0)" ::: "memory");
  float rli[16];
#pragma unroll
  for (int r = 0; r < 16; ++r) rli[r] = __builtin_amdgcn_rcpf(li_l[crow(r, hi)]);
  bf16_t* Ow = Ob + (size_t)(wid * 32) * LDO;
#pragma unroll
  for (int r = 0; r < 16; ++r) { const int orow = crow(r, hi);
#pragma unroll
    for (int d0 = 0; d0 < 2; ++d0) Ow[(size_t)orow * LDO + d0 * 32 + r32] = (bf16_t)(cvtpk(o[d0][r] * rli[r], 0.f) & 0xffffu); }
  __syncthreads();
#undef KEYBASE
#undef SLOAD
#undef SWRITE
#undef SWAIT
#undef RESC
#undef MASK
}
#undef KSWZ
#undef SBAR
}
namespace cg = cooperative_groups;
#define LAS __attribute__((address_space(3)))
typedef unsigned short bf16;
typedef unsigned v4u __attribute__((ext_vector_type(4)));
typedef float f32x4 __attribute__((ext_vector_type(4)));
__device__ __forceinline__ unsigned f2bf(float f) { unsigned u = __builtin_bit_cast(unsigned, f); return (u + 0x7fffu + ((u >> 16) & 1u)) >> 16; }
__device__ __forceinline__ unsigned pk2(float lo, float hi) { return f2bf(lo) | (f2bf(hi) << 16); }
__device__ __forceinline__ float wave_sum(float v) {
#pragma unroll
    for (int o = 1; o < 64; o <<= 1) v += __shfl_xor(v, o);
    return v;
}
#define LDS_WAIT() asm volatile("s_waitcnt lgkmcnt(0)" ::: "memory")
__device__ __forceinline__ int pperm(int d) { return d < 16 ? 8 * (d >> 2) + (d & 3) : 8 * ((d - 16) >> 2) + 4 + (d & 3); }
__device__ __forceinline__ int dstcol(int mat, int n) {
    if (mat == 0) { if (n < 1536) return n; if (n < 1920) return n - 1536 + 3840; if (n < 2176) return n - 1920 + 1536; if (n < 2208) return 4224 + pperm(n - 2176); if (n < 3232) return n - 2208 + 1792; return n - 3232 + 2816; }
    if (mat == 1) { const int h = n / 96, j = n % 96; return j < 64 ? h * 64 + j : 512 + h * 32 + pperm(j - 64); }
    if (mat == 2) { const int h = n >> 7, j = n & 127; return j < 64 ? h * 64 + j : 512 + h * 64 + (j - 64); }
    return n;
}
__device__ __forceinline__ void p0_transpose_item(const float* W, int K, int N, bf16* WT, const float* gain, int mat, LAS float* scr, int item, int lane) {
    const int nblk = N / 32, kb = item / nblk, nb = item % nblk, k0 = 64 * kb, n0 = 32 * nb;
#pragma unroll 8
    for (int i = 0; i < 32; ++i) { const int kk = 2 * i + (lane >> 5); const float g = gain ? gain[k0 + kk] : 1.f; scr[kk * 33 + (lane & 31)] = W[(size_t)(k0 + kk) * N + n0 + (lane & 31)] * g; }
    LDS_WAIT(); asm volatile("" ::: "memory");
    const int c = lane & 7;
#pragma unroll
    for (int j = 0; j < 4; ++j) { const int n = (lane >> 3) + 8 * j; const LAS float* s = scr + (8 * c) * 33 + n;
        v4u o; o.x = pk2(s[0 * 33], s[1 * 33]); o.y = pk2(s[2 * 33], s[3 * 33]); o.z = pk2(s[4 * 33], s[5 * 33]); o.w = pk2(s[6 * 33], s[7 * 33]);
        *(v4u*)(WT + (size_t)dstcol(mat, n0 + n) * K + k0 + 8 * c) = o; }
    LDS_WAIT(); asm volatile("" ::: "memory");
}
__device__ __forceinline__ void rms_row_to_bf16(const float* xrow, bf16* orow, int lane) {
    const f32x4* xr = (const f32x4*)xrow + lane;
    f32x4 v[4]; float s = 0.f;
#pragma unroll
    for (int j = 0; j < 4; ++j) { v[j] = xr[64 * j]; s += (v[j].x * v[j].x + v[j].y * v[j].y) + (v[j].z * v[j].z + v[j].w * v[j].w); }
    const float rstd = 1.f / sqrtf(wave_sum(s) * (1.f / DM) + EPS);
    unsigned long long* o8 = (unsigned long long*)orow + lane;
#pragma unroll
    for (int j = 0; j < 4; ++j) o8[64 * j] = (unsigned long long)pk2(v[j].x * rstd, v[j].y * rstd) | ((unsigned long long)pk2(v[j].z * rstd, v[j].w * rstd) << 32);
}

struct Args { const float* in[16]; float* out; unsigned char* ws; };

__device__ __forceinline__ void meta_part1(const float* meta, const float* norm_mix, const float* w_in, float* MP, LAS float* L, int ci, int tid) {
    const int wave = tid >> 6, lane = tid & 63;
    for (int j = wave; j < 16; j += 8) {
        float x[16]; float s = 0.f;
#pragma unroll
        for (int i = 0; i < 16; ++i) { x[i] = meta[j * 1024 + lane + 64 * i]; s += x[i] * x[i]; }
        const float rstd = 1.f / sqrtf(wave_sum(s) * (1.f / 1024.f) + EPS);
#pragma unroll
        for (int i = 0; i < 16; ++i) L[j * 1024 + lane + 64 * i] = x[i] * rstd * norm_mix[lane + 64 * i];
    }
    __syncthreads();
    const int n0 = ci < 32 ? 512 + 32 * ci : 1920 + 32 * (ci - 32);
    const int col = lane & 31, part = wave * 2 + (lane >> 5), kb = part * 64;
    float acc[16];
#pragma unroll
    for (int j = 0; j < 16; ++j) acc[j] = 0.f;
    for (int k = kb; k < kb + 64; k += 4) {
        const float w0 = w_in[(size_t)k * D_IN + n0 + col], w1 = w_in[(size_t)(k + 1) * D_IN + n0 + col], w2 = w_in[(size_t)(k + 2) * D_IN + n0 + col], w3 = w_in[(size_t)(k + 3) * D_IN + n0 + col];
#pragma unroll
        for (int j = 0; j < 16; ++j) { const f32x4 h = *(const LAS f32x4*)(L + j * 1024 + k); acc[j] += (h.x * w0 + h.y * w1) + (h.z * w2 + h.w * w3); }
    }
#pragma unroll
    for (int j = 0; j < 16; ++j) L[16384 + (part * 16 + j) * 32 + col] = acc[j];
    __syncthreads();
    { const int j = tid >> 5, c = tid & 31; float s = 0.f;
#pragma unroll
      for (int p = 0; p < 16; ++p) s += L[16384 + (p * 16 + j) * 32 + c];
      MP[j * 1312 + 32 * ci + c] = s; }
    __syncthreads();
}
__device__ __forceinline__ void meta_part2(const float* MP, const float* kvn, const float* w_ukv, const float* rope, bf16* KNA, bf16* VNA, bf16* KM, bf16* VM, LAS float* L, int tid) {
    const int wave = tid >> 6, lane = tid & 63;
    for (int idx = tid; idx < 16 * 1024; idx += 512) { const int j = idx >> 10, c = idx & 1023; const bf16 v = (bf16)f2bf(MP[j * 1312 + c]); bf16* dst = c < 512 ? KNA : VNA;
#pragma unroll
        for (int b = 0; b < BATCH; ++b) dst[(size_t)(b * KPB + j) * 512 + (c & 511)] = v; }
    for (int j = wave; j < 16; j += 8) {
        float x[4]; float s = 0.f;
#pragma unroll
        for (int i = 0; i < 4; ++i) { x[i] = MP[j * 1312 + 1024 + lane + 64 * i]; s += x[i] * x[i]; }
        const float rstd = 1.f / sqrtf(wave_sum(s) * (1.f / 256.f) + EPS);
#pragma unroll
        for (int i = 0; i < 4; ++i) L[j * 256 + lane + 64 * i] = x[i] * rstd * kvn[lane + 64 * i];
    }
    __syncthreads();
    for (int q = 0; q < 4; ++q) {
        const int n0 = (wave * 4 + q) * 32, col = lane & 31, half = lane >> 5;
        float acc[16];
#pragma unroll
        for (int j = 0; j < 16; ++j) acc[j] = 0.f;
        for (int k = half * 128; k < half * 128 + 128; k += 4) {
            const float w0 = w_ukv[(size_t)k * 1024 + n0 + col], w1 = w_ukv[(size_t)(k + 1) * 1024 + n0 + col], w2 = w_ukv[(size_t)(k + 2) * 1024 + n0 + col], w3 = w_ukv[(size_t)(k + 3) * 1024 + n0 + col];
#pragma unroll
            for (int j = 0; j < 16; ++j) { const f32x4 h = *(const LAS f32x4*)(L + j * 256 + k); acc[j] += (h.x * w0 + h.y * w1) + (h.z * w2 + h.w * w3); }
        }
#pragma unroll
        for (int j = 0; j < 16; ++j) acc[j] += __shfl_xor(acc[j], 32);
        if (half == 0) { const int n = n0 + col, h = n >> 7, jj = n & 127;
#pragma unroll
            for (int j = 0; j < 16; ++j) { const bf16 v = (bf16)f2bf(acc[j]);
#pragma unroll
                for (int b = 0; b < BATCH; ++b) { if (jj < 64) KM[(size_t)(b * KPB + j) * 768 + h * 96 + jj] = v; else VM[(size_t)(b * KPB + j) * 512 + h * 64 + (jj - 64)] = v; } } }
    }
    if (tid < 256) { const int j = tid >> 4, i = tid & 15; const float x1 = MP[j * 1312 + 1280 + i], x2 = MP[j * 1312 + 1296 + i], c = rope[(j * 16 + i) * 2], s = rope[(j * 16 + i) * 2 + 1];
        const bf16 o1 = (bf16)f2bf(x1 * c - x2 * s), o2 = (bf16)f2bf(x2 * c + x1 * s); const int p1 = pperm(i), p2 = pperm(16 + i);
        for (int b = 0; b < BATCH; ++b) for (int h = 0; h < 8; ++h) { KM[(size_t)(b * KPB + j) * 768 + h * 96 + 64 + p1] = o1; KM[(size_t)(b * KPB + j) * 768 + h * 96 + 64 + p2] = o2; } }
    __syncthreads();
}


#define GRID_SYNC() do { asm volatile("s_waitcnt vmcnt(0)" ::: "memory"); grid.sync(); \
    if (wave == 0) { __builtin_amdgcn_fence(__ATOMIC_ACQUIRE, "agent"); asm volatile("s_waitcnt vmcnt(0)" ::: "memory"); } __syncthreads(); } while (0)
__global__ void __launch_bounds__(NWAVES * 64, 2) mega_fwd(Args a) {
    extern __shared__ __attribute__((aligned(16))) unsigned char lds[];
    cg::grid_group grid = cg::this_grid();
    LAS unsigned char* L3 = (LAS unsigned char*)lds;
    const int tid = threadIdx.x, lane = tid & 63, wave = __builtin_amdgcn_readfirstlane(tid >> 6);
    const int G = gridDim.x, bx = blockIdx.x; const int vcu = (G % 8 == 0) ? (bx % 8) * (G / 8) + bx / 8 : bx;
    unsigned char* ws = a.ws;
    const float *x = a.in[0], *meta = a.in[1], *norm_mix = a.in[2], *w_in = a.in[3], *na_rpb = a.in[4], *q_norm = a.in[5], *w_uq = a.in[6], *kv_norm = a.in[7], *w_ukv = a.in[8],
                *w_na_out = a.in[9], *w_mla_out = a.in[10], *w_out = a.in[11], *norm_ffn = a.in[12], *w_ff1 = a.in[13], *w_ff2 = a.in[14], *norm_final = a.in[15];
    float* out = a.out;
    float* ROPE = (float*)(ws + WS_ROPE); float* MP = (float*)(ws + WS_MP);
    bf16 *Win_t = (bf16*)(ws + WS_WIN), *Wuq_t = (bf16*)(ws + WS_WUQ), *Wukv_t = (bf16*)(ws + WS_WUKV), *Wna_t = (bf16*)(ws + WS_WNA), *Wmla_t = (bf16*)(ws + WS_WMLA), *Wout_t = (bf16*)(ws + WS_WOUT),
         *Wff1_t = (bf16*)(ws + WS_WFF1), *Wff2_t = (bf16*)(ws + WS_WFF2);
    bf16 *HN = (bf16*)(ws + WS_HN), *QM = (bf16*)(ws + WS_QM), *MG = (bf16*)(ws + WS_MG), *QNA = (bf16*)(ws + WS_QNA), *H2B = (bf16*)(ws + WS_H2B), *KNA = (bf16*)(ws + WS_KNA), *VNA = (bf16*)(ws + WS_VNA),
         *CQ = (bf16*)((unsigned char*)a.out + DO_CQ), *CKV = (bf16*)((unsigned char*)a.out + DO_CKV), *ONA = (bf16*)((unsigned char*)a.out + DO_ONA), *TB = (bf16*)((unsigned char*)a.out + DO_T), *KM = (bf16*)(ws + WS_KM), *VM = (bf16*)(ws + WS_VM), *GNA = (bf16*)(ws + WS_GNA), *GMLA = (bf16*)(ws + WS_GMLA), *OMLA = (bf16*)((unsigned char*)a.out + DO_OMLA), *U = (bf16*)(ws + WS_U);
    float *SSQ_CKV = (float*)(ws + WS_SSQ_CKV), *SSQ_CQ = (float*)(ws + WS_SSQ_CQ), *SSQ_H2 = (float*)(ws + WS_SSQ_H2), *SSQ_H3 = (float*)(ws + WS_SSQ_H3);

#ifndef NO_P0
    {
        for (int ci = bx; ci < 41; ci += G) meta_part1(meta, norm_mix, w_in, MP, (LAS float*)L3, ci, tid);
        LAS float* scr = (LAS float*)(L3 + wave * 16384);
        const int gw = vcu * NWAVES + wave, NGW = G * NWAVES;
        constexpr int I_IN = (DM / 64) * (D_IN / 32), I_UQ = (384 / 64) * (768 / 32), I_UKV = (256 / 64) * (1024 / 32), I_NA = (512 / 64) * (1024 / 32), I_OUT = (DM / 64) * (DM / 32),
                      I_F1 = (DM / 64) * (FF / 32), I_F2 = (FF / 64) * (DM / 32), NITEMS = I_IN + I_UQ + I_UKV + 2 * I_NA + I_OUT + I_F1 + I_F2;
        for (int it = gw; it < NITEMS; it += NGW) {
            int r = it;
            if (r < I_IN) { p0_transpose_item(w_in, DM, D_IN, Win_t, norm_mix, 0, scr, r, lane); continue; } r -= I_IN;
            if (r < I_UQ) { p0_transpose_item(w_uq, 384, 768, Wuq_t, q_norm, 1, scr, r, lane); continue; } r -= I_UQ;
            if (r < I_UKV) { p0_transpose_item(w_ukv, 256, 1024, Wukv_t, kv_norm, 2, scr, r, lane); continue; } r -= I_UKV;
            if (r < I_NA) { p0_transpose_item(w_na_out, 512, 1024, Wna_t, nullptr, 3, scr, r, lane); continue; } r -= I_NA;
            if (r < I_NA) { p0_transpose_item(w_mla_out, 512, 1024, Wmla_t, nullptr, 3, scr, r, lane); continue; } r -= I_NA;
            if (r < I_OUT) { p0_transpose_item(w_out, DM, DM, Wout_t, nullptr, 3, scr, r, lane); continue; } r -= I_OUT;
            if (r < I_F1) { p0_transpose_item(w_ff1, DM, FF, Wff1_t, norm_ffn, 3, scr, r, lane); continue; } r -= I_F1;
            p0_transpose_item(w_ff2, FF, DM, Wff2_t, nullptr, 3, scr, r, lane);
        }
        for (int m = gw; m < M; m += NGW) rms_row_to_bf16(x + (size_t)m * DM, HN + (size_t)m * DM, lane);
        const int gt = bx * (NWAVES * 64) + tid, NGT = G * NWAVES * 64;
        for (int e = gt; e < LTOT * 16; e += NGT) {
            const int pos = e >> 4, i = e & 15;
            const float inv = __builtin_amdgcn_exp2f(-(float)i * (13.287712379549449f / 16.0f));
            const float ang = (float)pos * inv;
            double rev = (double)ang * 0.15915494309189535; rev -= __builtin_rint(rev);
            const float rv = (float)rev;
            ROPE[2 * e] = __builtin_amdgcn_cosf(rv); ROPE[2 * e + 1] = __builtin_amdgcn_sinf(rv);
        }
        const v4u z = {0u, 0u, 0u, 0u};
        for (int e = gt; e < 96 * 128; e += NGT) *(v4u*)(Win_t + (size_t)D_IN * DM + (size_t)e * 8) = z;
        for (int e = gt; e < BATCH * 112 * 288; e += NGT) {
            const int c = e % 288, rr = e / 288, b = rr / 112, kr = LTOT + rr % 112; const size_t row = (size_t)b * KPB + kr;
            if (c < 64) *(v4u*)(KNA + row * 512 + c * 8) = z; else if (c < 128) *(v4u*)(VNA + row * 512 + (c - 64) * 8) = z;
            else if (c < 224) *(v4u*)(KM + row * 768 + (c - 128) * 8) = z; else *(v4u*)(VM + row * 512 + (c - 224) * 8) = z;
        }
    }
#endif
    GRID_SYNC();
#ifndef NO_P1
    {
        if (bx == G - 1) meta_part2(MP, kv_norm, w_ukv, ROPE, KNA, VNA, KM, VM, (LAS float*)L3, tid);
        pg8::Gemm g{HN, Win_t, nullptr, nullptr, M, N_IN, DM}; pg8::StaticOrder S; S.init(M, N_IN, G, bx);
        pg8::EpiP1 E{ws, CKV, CQ, KM, SSQ_CKV, SSQ_CQ, ROPE};
        pg8::gemm_phase<pg8::EpiP1, pg8::StaticOrder, true, true>(L3, g, S, E);
    }
#endif
    GRID_SYNC();
#ifndef NO_P2
    {
#ifndef NO_P2A
        { pg8::Gemm g{CQ, Wuq_t, nullptr, nullptr, M, 768, 384}; pg8::StaticOrder S; S.init(M, 768, G, bx);
          pg8::EpiP2Q E{QM, SSQ_CQ, ROPE};
          pg8::gemm_phase<pg8::EpiP2Q, pg8::StaticOrder, false, true>(L3, g, S, E); }
#endif
        __syncthreads();
#ifndef NO_P2B
        { pg8::Gemm g{CKV, Wukv_t, nullptr, nullptr, M, 1024, 256}; pg8::StaticOrder S; S.init(M, 1024, G, bx);
          pg8::EpiP2KV E{KM, VM, SSQ_CKV};
          pg8::gemm_phase<pg8::EpiP2KV, pg8::StaticOrder, false, true>(L3, g, S, E); }
#endif
    }
#endif
    GRID_SYNC();
#ifndef NO_P3
    {
        for (int u = vcu; u < 1024; u += G) {
            if (u < 512) { const int bh = u >> 4, qb = u & 15, b = bh >> 3, h = bh & 7;
                att::attn_unit<96, false>(QM + (size_t)(b * SEQ + 256 * qb) * 768 + h * 96, KM + (size_t)b * KPB * 768 + h * 96, VM + (size_t)b * KPB * 512 + h * 64,
                                          OMLA + (size_t)(b * SEQ + 256 * qb) * 512 + h * 64, 66, 0, 0, 0, nullptr, (char*)lds);
            } else { const int v = u - 512, bh = v >> 4, rg = v & 15, b = bh >> 3, h = bh & 7, r0 = 4 * rg;
                const int krow0 = min(max(r0 - 4, 0), 56), klast = min(max(r0 + 3 - 4, 0), 56) + 7, nkr = klast - krow0 + 1; const int NT = (1 + nkr + 1) & ~1;
                att::attn_unit<64, true>(QNA + (size_t)(b * SEQ + 256 * rg) * 512 + h * 64, KNA + (size_t)b * KPB * 512 + h * 64, VNA + (size_t)b * KPB * 512 + h * 64,
                                         ONA + (size_t)(b * SEQ + 256 * rg) * 512 + h * 64, NT, r0, krow0, nkr, na_rpb + h * 15 * 31, (char*)lds);
            }
        }
    }
#endif
    GRID_SYNC();
#ifndef NO_P4
    {
        pg8::Gemm g{ONA, Wna_t, nullptr, nullptr, M, DM, 512}; pg8::StaticOrder S; S.init(M, DM, G, bx);
        pg8::EpiP4 E{ws, TB, MG, 0};
        pg8::gemm_phase<pg8::EpiP4, pg8::StaticOrder, false, true>(L3, g, S, E);
    }
    GRID_SYNC();
    {
        pg8::Gemm g{OMLA, Wmla_t, nullptr, nullptr, M, DM, 512}; pg8::StaticOrder S; S.init(M, DM, G, bx);
        pg8::EpiP4 E{ws, TB, MG, 1};
        pg8::gemm_phase<pg8::EpiP4, pg8::StaticOrder, false, true>(L3, g, S, E);
    }
#endif
    GRID_SYNC();
#ifndef NO_P5
    {
        pg8::Gemm g{MG, Wout_t, nullptr, nullptr, M, DM, DM}; pg8::StaticOrder S; S.init(M, DM, G, bx);
        pg8::EpiP5 E{x, out, H2B, SSQ_H2};
        pg8::gemm_phase<pg8::EpiP5, pg8::StaticOrder, false, true>(L3, g, S, E);
    }
#endif
    GRID_SYNC();
#ifndef NO_P6
    {
        pg8::Gemm g{H2B, Wff1_t, nullptr, nullptr, M, FF, DM}; pg8::StaticOrder S; S.init(M, FF, G, bx);
        pg8::EpiP6 E{U, SSQ_H2};
        pg8::gemm_phase<pg8::EpiP6, pg8::StaticOrder, true, true>(L3, g, S, E);
    }
#endif
    GRID_SYNC();
#ifndef NO_P7
    {
        pg8::Gemm g{U, Wff2_t, nullptr, nullptr, M, DM, FF}; pg8::StaticOrder S; S.init(M, DM, G, bx);
        pg8::EpiP7 E{out, SSQ_H3};
        pg8::gemm_phase<pg8::EpiP7, pg8::StaticOrder, false, true>(L3, g, S, E);
    }
#endif
    GRID_SYNC();
#ifndef NO_P8
    {
        pg8::StaticOrder S; S.init(M, DM, G, bx); pg8::Unit u;
        for (int i = 0; S.next(i, u); ++i) {
            const f32x4 gn = *((const f32x4*)(norm_final + u.pn * 256) + lane);
            for (int r = 0; r < 32; ++r) { const int row = u.pm * 256 + wave * 32 + r;
                const float rstd = 1.f / sqrtf(pg8::sum16(SSQ_H3 + (size_t)row * 16) * (1.f / DM) + EPS);
                f32x4* rp = (f32x4*)(out + (size_t)row * DM + u.pn * 256) + lane; *rp = *rp * rstd * gn; }
        }
    }
#endif
}

constexpr int LDS_BYTES = 131072 + 2048;
extern "C" void kernel_launch(void* const* d_in, const int* in_sizes, int n_in, void* d_out, int out_size, void* d_ws, size_t ws_size, hipStream_t stream) {
    static int grid = 0;
    if (grid == 0) {
        if (n_in != 16 || out_size != M * DM || ws_size < WS_END) { fprintf(stderr, "kernel_launch: unexpected shapes (n_in %d out %d ws %zu)\n", n_in, out_size, ws_size); grid = -1; return; }
        int dev = 0, cus = 0, per_cu = 0;
        hipGetDevice(&dev); hipDeviceGetAttribute(&cus, hipDeviceAttributeMultiprocessorCount, dev);
        hipFuncSetAttribute((const void*)mega_fwd, hipFuncAttributeMaxDynamicSharedMemorySize, LDS_BYTES);
        if (hipOccupancyMaxActiveBlocksPerMultiprocessor(&per_cu, (const void*)mega_fwd, NWAVES * 64, LDS_BYTES) != hipSuccess || per_cu < 1) { fprintf(stderr, "kernel_launch: occupancy query failed (%d)\n", per_cu); (void)hipGetLastError(); per_cu = 1; }
        grid = cus;
    }
    if (grid < 0) return;
    Args a{};
    for (int i = 0; i < 16; ++i) a.in[i] = (const float*)d_in[i];
    a.out = (float*)d_out; a.ws = (unsigned char*)d_ws;
    void* args[] = {&a};
    hipError_t e = hipLaunchCooperativeKernel((const void*)mega_fwd, dim3(grid), dim3(NWAVES * 64), args, LDS_BYTES, stream);
    if (e != hipSuccess) fprintf(stderr, "kernel_launch: cooperative launch failed: %s (grid %d)\n", hipGetErrorString(e), grid);
}
```

```cpp
#include <hip/hip_runtime.h>
#include <hip/hip_cooperative_groups.h>
#include <cstdio>
#include <cstdint>
constexpr int NWAVES = 8;
constexpr int BATCH = 4, SEQ = 4096, DM = 1024, NMETA = 16, M = BATCH * SEQ, KPB = 4224  , LTOT = 4112;
constexpr int D_IN = 4256, N_IN = 4352, FF = 4096;
constexpr float EPS = 1e-6f;
constexpr size_t MiB = 1u << 20;
constexpr size_t WS_ROPE = 0, WS_MP = 786432, WS_BAR = 917504  ;
constexpr size_t WS_WIN = 1 * MiB, WS_WUQ = 9 * MiB + 512 * 1024, WS_WUKV = 10 * MiB + 256 * 1024, WS_WNA = 11 * MiB, WS_WMLA = 12 * MiB, WS_WOUT = 13 * MiB, WS_WFF1 = 15 * MiB, WS_WFF2 = 23 * MiB;
constexpr size_t WS_SSQ_CKV = 31 * MiB;
constexpr size_t WS_HN = 32 * MiB, WS_MG = 32 * MiB;
constexpr size_t WS_QNA = 64 * MiB, WS_H2B = 64 * MiB, WS_KNA = 80 * MiB, WS_VNA = 96 * MiB + 512 * 1024, WS_QM = 113 * MiB, WS_KM = 137 * MiB, WS_VM = 162 * MiB;
constexpr size_t WS_GNA = 179 * MiB, WS_GMLA = 211 * MiB, WS_SSQ_CQ = 243 * MiB, WS_SSQ_H2 = 244 * MiB, WS_SSQ_H3 = 245 * MiB, WS_END = 256 * MiB;
constexpr size_t WS_U = 97 * MiB;
constexpr size_t DO_CQ = 0, DO_CKV = 12 * MiB, DO_T = 0, DO_ONA = 32 * MiB, DO_OMLA = 48 * MiB;
static_assert(WS_WIN + (size_t)N_IN * DM * 2 <= WS_WUQ && WS_WUQ + 768 * 384 * 2 <= WS_WUKV && WS_WUKV + 1024 * 256 * 2 <= WS_WNA && WS_WFF2 + (size_t)DM * FF * 2 <= WS_SSQ_CKV, "weights map");
static_assert(WS_SSQ_CKV + (size_t)M * 8 * 4 <= WS_HN && WS_KNA + (size_t)BATCH * KPB * 512 * 2 <= WS_VNA && WS_VNA + (size_t)BATCH * KPB * 512 * 2 <= WS_QM && WS_QM + (size_t)M * 768 * 2 <= WS_KM, "map 1");
static_assert(WS_KM + (size_t)BATCH * KPB * 768 * 2 <= WS_VM && WS_VM + (size_t)BATCH * KPB * 512 * 2 <= WS_GNA && WS_GMLA + (size_t)M * DM * 2 <= WS_SSQ_CQ && WS_SSQ_H3 + (size_t)M * 64 <= WS_END, "map 2");
static_assert(WS_U + (size_t)M * FF * 2 <= WS_SSQ_CQ && WS_H2B + (size_t)M * DM * 2 <= WS_U && WS_MP + 16 * 1312 * 4 <= WS_WIN && (size_t)LTOT * 32 * 4 <= WS_MP && DO_CKV + (size_t)M * 256 * 2 <= DO_ONA, "map 3");
namespace pg8 {
#define PG8_LAS __attribute__((address_space(3)))
typedef unsigned short bf16_t;
typedef short bf16x8 __attribute__((ext_vector_type(8)));
typedef float f32x4 __attribute__((ext_vector_type(4)));
typedef unsigned u32x4 __attribute__((ext_vector_type(4)));
constexpr int BM = 256, BK = 64, HALF = 128, HTB = HALF * BK * 2  , STAGE_BYTES = 8 * HTB, NXCD = 8, WGM = 8;

__host__ __device__ __forceinline__ int lds_byte(int r, int c) { const int st = (r >> 4) * 2 + (c >> 5), rr = r & 15, cc = c & 31, ob = rr * 64 + cc * 2; return st * 1024 + (ob ^ (((ob >> 9) & 1) << 5)); }
__host__ __device__ __forceinline__ void stage_rc(int b, int& R, int& C) { const int st = b / 1024, sb = b % 1024, swz = sb ^ (((sb >> 9) & 1) << 5); R = (st >> 1) * 16 + swz / 64; C = (st & 1) * 32 + (swz % 64) / 2; }
__host__ __device__ __forceinline__ int perm32(int rho) { const int n = rho >> 4, i = rho & 15; return 8 * (i >> 2) + 4 * n + (i & 3); }

struct Unit { int pm, pn, g; };
struct Gemm { const bf16_t* A; const bf16_t* Bt; const bf16_t* A1; const bf16_t* Bt1; int M, N, K; };

struct StaticOrder {
    int nM, nN, nwg, G, c;
    __host__ __device__ __forceinline__ void init(int M, int N, int G_, int c_) { nM = M / BM; nN = N / BM; nwg = nM * nN; G = G_; c = c_; }
    __host__ __device__ __forceinline__ bool next(int i, Unit& u) const {
        const long L = (long)i * G + c; if (L >= nwg) return false;
        int wgid = (int)L; { const int q = nwg / NXCD, r = nwg % NXCD, xcd = wgid % NXCD, off = wgid / NXCD; wgid = (xcd < r ? xcd * (q + 1) : r * (q + 1) + (xcd - r) * q) + off; }
        const int nig = WGM * nN, gid = wgid / nig, fm = gid * WGM, gsz = (nM - fm) < WGM ? (nM - fm) : WGM;
        u.pm = fm + ((wgid % nig) % gsz); u.pn = (wgid % nig) / gsz; u.g = 0; return true;
    }
    __device__ __forceinline__ void a_ready(const Unit&) const {}
    __device__ __forceinline__ void done(const Unit&) const {}
};

typedef float f32x2 __attribute__((ext_vector_type(2)));
typedef __bf16 bf16x2_cv __attribute__((ext_vector_type(2)));
__device__ __forceinline__ unsigned cvt_pk_bf16(float lo, float hi) { const f32x2 v = {lo, hi}; const bf16x2_cv b = __builtin_convertvector(v, bf16x2_cv); return __builtin_bit_cast(unsigned, b); }
__device__ __forceinline__ u32x4 pack8(const f32x4 a, const f32x4 b) { u32x4 w; w.x = cvt_pk_bf16(a[0], a[1]); w.y = cvt_pk_bf16(a[2], a[3]); w.z = cvt_pk_bf16(b[0], b[1]); w.w = cvt_pk_bf16(b[2], b[3]); return w; }
__device__ __forceinline__ void unpack8(const u32x4 w, f32x4& a, f32x4& b) {
    a[0] = __uint_as_float(w.x << 16); a[1] = __uint_as_float(w.x & 0xffff0000u); a[2] = __uint_as_float(w.y << 16); a[3] = __uint_as_float(w.y & 0xffff0000u);
    b[0] = __uint_as_float(w.z << 16); b[1] = __uint_as_float(w.z & 0xffff0000u); b[2] = __uint_as_float(w.w << 16); b[3] = __uint_as_float(w.w & 0xffff0000u); }
__device__ __forceinline__ float sigm(float x) { return __builtin_amdgcn_rcpf(1.f + __builtin_amdgcn_exp2f(-1.4426950408889634f * x)); }
__device__ __forceinline__ f32x4 sigm4(const f32x4 v) { f32x4 r; r[0] = sigm(v[0]); r[1] = sigm(v[1]); r[2] = sigm(v[2]); r[3] = sigm(v[3]); return r; }
__device__ __forceinline__ float sq4(const f32x4 v) { return (v[0] * v[0] + v[1] * v[1]) + (v[2] * v[2] + v[3] * v[3]); }
__device__ __forceinline__ float red_fq(float s) { s += __shfl_xor(s, 16); s += __shfl_xor(s, 32); return s; }
__device__ __forceinline__ int keyrow(int m) { return (m >> 12) * 4224 + 16 + (m & 4095); }
constexpr float RMS_EPS = 1e-6f;
__device__ __forceinline__ u32x4 rope8(const f32x4 x1, const f32x4 x2, const float* rope, int pos, int fq) {
    const f32x4* t = (const f32x4*)(rope + ((size_t)pos * 16 + 4 * fq) * 2); const f32x4 t0 = t[0], t1 = t[1];
    f32x4 o1, o2;
    o1[0] = x1[0] * t0[0] - x2[0] * t0[1]; o2[0] = x2[0] * t0[0] + x1[0] * t0[1];
    o1[1] = x1[1] * t0[2] - x2[1] * t0[3]; o2[1] = x2[1] * t0[2] + x1[1] * t0[3];
    o1[2] = x1[2] * t1[0] - x2[2] * t1[1]; o2[2] = x2[2] * t1[0] + x1[2] * t1[1];
    o1[3] = x1[3] * t1[2] - x2[3] * t1[3]; o2[3] = x2[3] * t1[2] + x1[3] * t1[3];
    return pack8(o1, o2);
}
#define EPI_ROWS _Pragma("unroll") for (int ai = 0; ai < 2; ++ai) _Pragma("unroll") for (int m = 0; m < 4; ++m)

struct EpiP1 {
    static constexpr bool PERM = true, AFTER_DRAIN = false;
    unsigned char* ws; bf16_t *CKV, *CQ, *KM; float *ssq_ckv, *ssq_cq; const float* rope;
    __device__ __forceinline__ void operator()(const f32x4 (&acc)[2][2][4][2], const Unit& u, int wr, int wc, int fr, int fq) const {
        { int t_ = threadIdx.x; asm volatile("" : "+v"(t_)); fr = t_ & 15; fq = (t_ >> 4) & 3; }
        const int row0 = u.pm * BM + wr * 64 + fr;
#pragma unroll
        for (int bj = 0; bj < 2; ++bj) {
            const int ct = u.pn * 2 + bj, cw = wc * 32 + 8 * fq;
            if (ct < 12) {
                const int which = ct >> 2; bf16_t* base = (bf16_t*)(ws + (which == 0 ? WS_QNA : (which == 1 ? WS_KNA : WS_VNA))); const int col = (ct & 3) * 128 + cw;
                EPI_ROWS { const int row = row0 + ai * HALF + m * 16; const int orow = which == 0 ? row : keyrow(row);
                    *(u32x4*)(base + (size_t)orow * 512 + col) = pack8(acc[ai][bj][m][0], acc[ai][bj][m][1]); }
            } else if (ct < 14) {
                const int col = (ct - 12) * 128 + cw, slot = (ct - 12) * 4 + wc;
                EPI_ROWS { const int row = row0 + ai * HALF + m * 16;
                    *(u32x4*)(CKV + (size_t)row * 256 + col) = pack8(acc[ai][bj][m][0], acc[ai][bj][m][1]);
                    const float s = red_fq(sq4(acc[ai][bj][m][0]) + sq4(acc[ai][bj][m][1])); if (fq == 0) ssq_ckv[(size_t)row * 8 + slot] = s; }
            } else if (ct < 30) {
                bf16_t* base = (bf16_t*)(ws + (ct < 22 ? WS_GNA : WS_GMLA)); const int col = ((ct - 14) & 7) * 128 + cw;
                EPI_ROWS { const int row = row0 + ai * HALF + m * 16;
                    *(u32x4*)(base + (size_t)row * 1024 + col) = pack8(sigm4(acc[ai][bj][m][0]), sigm4(acc[ai][bj][m][1])); }
            } else if (ct < 33) {
                const int col = (ct - 30) * 128 + cw, slot = (ct - 30) * 4 + wc;
                EPI_ROWS { const int row = row0 + ai * HALF + m * 16;
                    *(u32x4*)(CQ + (size_t)row * 384 + col) = pack8(acc[ai][bj][m][0], acc[ai][bj][m][1]);
                    const float s = red_fq(sq4(acc[ai][bj][m][0]) + sq4(acc[ai][bj][m][1])); if (fq == 0) ssq_cq[(size_t)row * 16 + slot] = s; }
            } else if (wc == 0) {
                EPI_ROWS { const int row = row0 + ai * HALF + m * 16; const int pos = 16 + (row & 4095);
                    const u32x4 w = rope8(acc[ai][bj][m][0], acc[ai][bj][m][1], rope, pos, fq);
                    bf16_t* kp = KM + (size_t)keyrow(row) * 768 + 64 + 8 * fq;
#pragma unroll
                    for (int h = 0; h < 8; ++h) *(u32x4*)(kp + h * 96) = w; }
            }
        }
    }
};
struct EpiP2Q {
    static constexpr bool PERM = true, AFTER_DRAIN = false;
    bf16_t* QM; const float* ssq_cq; const float* rope;
    __device__ __forceinline__ void operator()(const f32x4 (&acc)[2][2][4][2], const Unit& u, int wr, int wc, int fr, int fq) const {
        { int t_ = threadIdx.x; asm volatile("" : "+v"(t_)); fr = t_ & 15; fq = (t_ >> 4) & 3; }
        const int row0 = u.pm * BM + wr * 64 + fr;
        EPI_ROWS { const int row = row0 + ai * HALF + m * 16;
            const f32x4* sp = (const f32x4*)(ssq_cq + (size_t)row * 16); const f32x4 s0 = sp[0], s1 = sp[1], s2 = sp[2];
            const float ss = ((s0[0] + s0[1]) + (s0[2] + s0[3])) + ((s1[0] + s1[1]) + (s1[2] + s1[3])) + ((s2[0] + s2[1]) + (s2[2] + s2[3]));
            const float rstd = 1.0f / sqrtf(ss * (1.0f / 384.0f) + RMS_EPS);
#pragma unroll
            for (int bj = 0; bj < 2; ++bj) {
                const f32x4 v0 = acc[ai][bj][m][0] * rstd, v1 = acc[ai][bj][m][1] * rstd;
                if (u.pn < 2) { const int c = u.pn * 256 + bj * HALF + wc * 32 + 8 * fq; const int h = c >> 6, d = c & 63;
                    *(u32x4*)(QM + (size_t)row * 768 + h * 96 + d) = pack8(v0, v1); }
                else { const int h = bj * 4 + wc; const int pos = 16 + (row & 4095);
                    *(u32x4*)(QM + (size_t)row * 768 + h * 96 + 64 + 8 * fq) = rope8(v0, v1, rope, pos, fq); }
            } asm volatile("" ::: "memory"); }
    }
};
struct EpiP2KV {
    static constexpr bool PERM = true, AFTER_DRAIN = false;
    bf16_t *KM, *VM; const float* ssq_ckv;
    __device__ __forceinline__ void operator()(const f32x4 (&acc)[2][2][4][2], const Unit& u, int wr, int wc, int fr, int fq) const {
        { int t_ = threadIdx.x; asm volatile("" : "+v"(t_)); fr = t_ & 15; fq = (t_ >> 4) & 3; }
        const int row0 = u.pm * BM + wr * 64 + fr;
        EPI_ROWS { const int row = row0 + ai * HALF + m * 16; const size_t kr = (size_t)keyrow(row);
            const f32x4* sp = (const f32x4*)(ssq_ckv + (size_t)row * 8); const f32x4 s0 = sp[0], s1 = sp[1];
            const float ss = ((s0[0] + s0[1]) + (s0[2] + s0[3])) + ((s1[0] + s1[1]) + (s1[2] + s1[3]));
            const float rstd = 1.0f / sqrtf(ss * (1.0f / 256.0f) + RMS_EPS);
#pragma unroll
            for (int bj = 0; bj < 2; ++bj) {
                const f32x4 v0 = acc[ai][bj][m][0] * rstd, v1 = acc[ai][bj][m][1] * rstd;
                const int c = (u.pn & 1) * 256 + bj * HALF + wc * 32 + 8 * fq;
                if (u.pn < 2) { const int h = c >> 6, d = c & 63; *(u32x4*)(KM + kr * 768 + h * 96 + d) = pack8(v0, v1); }
                else *(u32x4*)(VM + kr * 512 + c) = pack8(v0, v1);
            } asm volatile("" ::: "memory"); }
    }
};
struct EpiP4 {
    static constexpr bool PERM = true, AFTER_DRAIN = false;
    unsigned char* ws; bf16_t* T; bf16_t* MG; int g;
    __device__ __forceinline__ void operator()(const f32x4 (&acc)[2][2][4][2], const Unit& u, int wr, int wc, int fr, int fq) const {
        { int t_ = threadIdx.x; asm volatile("" : "+v"(t_)); fr = t_ & 15; fq = (t_ >> 4) & 3; }
        const int row0 = u.pm * BM + wr * 64 + fr, col0 = u.pn * BM + wc * 32 + 8 * fq;
        EPI_ROWS { const int row = row0 + ai * HALF + m * 16;
#pragma unroll
            for (int bj = 0; bj < 2; ++bj) { const size_t off = (size_t)row * 1024 + col0 + bj * HALF;
                f32x4 g0, g1; unpack8(*(const u32x4*)((const bf16_t*)(ws + (g ? WS_GMLA : WS_GNA)) + off), g0, g1);
                const f32x4 v0 = acc[ai][bj][m][0] * g0, v1 = acc[ai][bj][m][1] * g1;
                if (g == 0) *(u32x4*)(T + off) = pack8(v0, v1);
                else { f32x4 t0, t1; unpack8(*(const u32x4*)(T + off), t0, t1); *(u32x4*)(MG + off) = pack8(t0 + v0, t1 + v1); }
            } asm volatile("" ::: "memory"); }
    }
};
struct EpiP5 {
    static constexpr bool PERM = true, AFTER_DRAIN = false;
    const float* X; float* H2; bf16_t* H2B; float* ssq;
    __device__ __forceinline__ void operator()(const f32x4 (&acc)[2][2][4][2], const Unit& u, int wr, int wc, int fr, int fq) const {
        { int t_ = threadIdx.x; asm volatile("" : "+v"(t_)); fr = t_ & 15; fq = (t_ >> 4) & 3; }
        const int row0 = u.pm * BM + wr * 64 + fr, col0 = u.pn * BM + wc * 32 + 8 * fq;
        EPI_ROWS { const int row = row0 + ai * HALF + m * 16; float s = 0.f;
#pragma unroll
            for (int bj = 0; bj < 2; ++bj) { const size_t off = (size_t)row * 1024 + col0 + bj * HALF;
                const f32x4 v0 = *(const f32x4*)(X + off) + acc[ai][bj][m][0], v1 = *(const f32x4*)(X + off + 4) + acc[ai][bj][m][1];
                *(f32x4*)(H2 + off) = v0; *(f32x4*)(H2 + off + 4) = v1; *(u32x4*)(H2B + off) = pack8(v0, v1); s += sq4(v0) + sq4(v1); }
            s = red_fq(s); if (fq == 0) ssq[(size_t)row * 16 + u.pn * 4 + wc] = s; asm volatile("" ::: "memory"); }
    }
};
__device__ __forceinline__ float sum16(const float* p) { const f32x4* q = (const f32x4*)p; const f32x4 a = q[0], b = q[1], c = q[2], d = q[3];
    return (((a[0] + a[1]) + (a[2] + a[3])) + ((b[0] + b[1]) + (b[2] + b[3]))) + (((c[0] + c[1]) + (c[2] + c[3])) + ((d[0] + d[1]) + (d[2] + d[3]))); }
struct EpiP6 {
    static constexpr bool PERM = true, AFTER_DRAIN = false;
    bf16_t* U; const float* ssq;
    __device__ __forceinline__ void operator()(const f32x4 (&acc)[2][2][4][2], const Unit& u, int wr, int wc, int fr, int fq) const {
        { int t_ = threadIdx.x; asm volatile("" : "+v"(t_)); fr = t_ & 15; fq = (t_ >> 4) & 3; }
        const int row0 = u.pm * BM + wr * 64 + fr, col0 = u.pn * BM + wc * 32 + 8 * fq;
        EPI_ROWS { const int row = row0 + ai * HALF + m * 16;
            const float rstd = 1.0f / sqrtf(sum16(ssq + (size_t)row * 16) * (1.0f / 1024.0f) + RMS_EPS);
#pragma unroll
            for (int bj = 0; bj < 2; ++bj) { const size_t off = (size_t)row * 4096 + col0 + bj * HALF;
                f32x4 v0 = acc[ai][bj][m][0] * rstd, v1 = acc[ai][bj][m][1] * rstd;
#pragma unroll
                for (int e = 0; e < 4; ++e) { const float a = fmaxf(v0[e], 0.f), b = fmaxf(v1[e], 0.f); v0[e] = a * a; v1[e] = b * b; }
                *(u32x4*)(U + off) = pack8(v0, v1); } asm volatile("" ::: "memory"); }
    }
};
struct EpiP7 {
    static constexpr bool PERM = true, AFTER_DRAIN = false;
    float* H; float* ssq;
    __device__ __forceinline__ void operator()(const f32x4 (&acc)[2][2][4][2], const Unit& u, int wr, int wc, int fr, int fq) const {
        { int t_ = threadIdx.x; asm volatile("" : "+v"(t_)); fr = t_ & 15; fq = (t_ >> 4) & 3; }
        const int row0 = u.pm * BM + wr * 64 + fr, col0 = u.pn * BM + wc * 32 + 8 * fq;
        EPI_ROWS { const int row = row0 + ai * HALF + m * 16; float s = 0.f;
#pragma unroll
            for (int bj = 0; bj < 2; ++bj) { const size_t off = (size_t)row * 1024 + col0 + bj * HALF;
                const f32x4 v0 = *(const f32x4*)(H + off) + acc[ai][bj][m][0], v1 = *(const f32x4*)(H + off + 4) + acc[ai][bj][m][1];
                *(f32x4*)(H + off) = v0; *(f32x4*)(H + off + 4) = v1; s += sq4(v0) + sq4(v1); }
            s = red_fq(s); if (fq == 0) ssq[(size_t)row * 16 + u.pn * 4 + wc] = s; asm volatile("" ::: "memory"); }
    }
};
struct PairOrder {
    StaticOrder so;
    __device__ __forceinline__ bool next(int i, Unit& u) const { if (!so.next(i >> 1, u)) return false; u.g = i & 1; return true; }
    __device__ __forceinline__ void a_ready(const Unit&) const {}
    __device__ __forceinline__ void done(const Unit&) const {}
};

template <class Epi, class Sched, bool ALIGN_EPI = false, bool SP2 = false>
__device__ __forceinline__ void gemm_phase(PG8_LAS unsigned char* lds, const Gemm g, const Sched& S, const Epi& E) {
    int tid_ = threadIdx.x; asm volatile("" : "+v"(tid_));
    const int tid = tid_, wid = __builtin_amdgcn_readfirstlane(tid >> 6), lane = tid & 63, wr = wid >> 2, wc = wid & 3, fr = lane & 15, fq = lane >> 4;
    int K_ = g.K; asm volatile("" : "+s"(K_));
    const int K = K_, nt = K / BK;
    unsigned voffA[2], voffB[2];
#pragma unroll
    for (int i = 0; i < 2; ++i) { int R, C; stage_rc(tid * 16 + i * 8192, R, C); const int Rb = Epi::PERM ? ((R & ~31) + perm32(R & 31)) : R;
        voffA[i] = (unsigned)(R * K + C) * 2u; voffB[i] = (unsigned)(Rb * K + C) * 2u; }
    const size_t kstep = (size_t)(BK * 2);
    const size_t hstep = (size_t)HALF * K * 2;
    const size_t tstep = 2 * hstep;
    const unsigned ldsw = (unsigned)wid * 1024u;
    const int aoff = lds_byte(wr * 64 + fr, fq * 8), boff = lds_byte(wc * 32 + fr, fq * 8);
#define PG8_SA(b, h) (((b) * 2 + (h)) * HTB)
#define PG8_SB(b, h) ((4 + (b) * 2 + (h)) * HTB)
#define PG8_STAGE(bufoff, gbase, voff) do { _Pragma("unroll") for (int _i = 0; _i < 2; ++_i) \
        __builtin_amdgcn_global_load_lds((const unsigned*)((const char*)(gbase) + (voff)[_i]), (PG8_LAS unsigned*)(lds + (bufoff) + ldsw + _i * 8192), 16, 0, 0); } while (0)
#define PG8_LDA(dst, b, h) do { _Pragma("unroll") for (int m = 0; m < 4; ++m) _Pragma("unroll") for (int k = 0; k < 2; ++k) dst[m][k] = *(const PG8_LAS bf16x8*)(lds + PG8_SA(b, h) + aoff + m * 2048 + k * 1024); } while (0)
#define PG8_LDB(dst, b, h) do { _Pragma("unroll") for (int n = 0; n < 2; ++n) _Pragma("unroll") for (int k = 0; k < 2; ++k) dst[n][k] = *(const PG8_LAS bf16x8*)(lds + PG8_SB(b, h) + boff + n * 2048 + k * 1024); } while (0)
#define PG8_MMA(ai, bj, At, Bt) do { __builtin_amdgcn_s_setprio(1); _Pragma("unroll") for (int m = 0; m < 4; ++m) _Pragma("unroll") for (int n = 0; n < 2; ++n) _Pragma("unroll") for (int k = 0; k < 2; ++k) \
        acc[ai][bj][m][n] = __builtin_amdgcn_mfma_f32_16x16x32_bf16(Bt[n][k], At[m][k], acc[ai][bj][m][n], 0, 0, 0); __builtin_amdgcn_s_setprio(0); } while (0)
#define PG8_WAIT_V(n) asm volatile("s_waitcnt vmcnt(" #n ")" ::: "memory")
#define PG8_WAIT_L(n) asm volatile("s_waitcnt lgkmcnt(" #n ")" ::: "memory")
#define PG8_BAR __builtin_amdgcn_s_barrier()
#define PG8_SCHED __builtin_amdgcn_sched_barrier(0)
    Unit cur, nxt; int ui = 0;
    if (!S.next(0, cur)) return;
    f32x4 acc[2][2][4][2];
#pragma unroll
    for (int a = 0; a < 2; ++a)
#pragma unroll
        for (int b = 0; b < 2; ++b)
#pragma unroll
            for (int m = 0; m < 4; ++m)
#pragma unroll
                for (int n = 0; n < 2; ++n) acc[a][b][m][n] = (f32x4){0.f, 0.f, 0.f, 0.f};
    bf16x8 At[4][2], B0[2][2], B1[2][2];
    const char* cA = (const char*)(cur.g ? g.A1 : g.A) + (size_t)cur.pm * tstep; const char* cB = (const char*)(cur.g ? g.Bt1 : g.Bt) + (size_t)cur.pn * tstep;
    S.a_ready(cur);
    if constexpr (SP2) {
        PG8_STAGE(PG8_SB(0, 0), cB, voffB); PG8_STAGE(PG8_SB(0, 1), cB + hstep, voffB); PG8_STAGE(PG8_SA(0, 0), cA, voffA); PG8_STAGE(PG8_SA(0, 1), cA + hstep, voffA);
        if (wr == 1) PG8_BAR;
        PG8_WAIT_V(2); PG8_BAR;
        PG8_STAGE(PG8_SB(1, 0), cB + kstep, voffB); PG8_STAGE(PG8_SA(1, 0), cA + kstep, voffA); PG8_STAGE(PG8_SB(1, 1), cB + hstep + kstep, voffB);
        PG8_WAIT_V(6); PG8_BAR;
    } else {
        PG8_STAGE(PG8_SB(0, 0), cB, voffB); PG8_STAGE(PG8_SA(0, 0), cA, voffA); PG8_STAGE(PG8_SB(0, 1), cB + hstep, voffB); PG8_STAGE(PG8_SA(0, 1), cA + hstep, voffA);
        if (wr == 1) PG8_BAR;
        PG8_WAIT_V(4); PG8_BAR;
        PG8_STAGE(PG8_SB(1, 0), cB + kstep, voffB); PG8_STAGE(PG8_SA(1, 0), cA + kstep, voffA); PG8_STAGE(PG8_SB(1, 1), cB + hstep + kstep, voffB);
        PG8_WAIT_V(6); PG8_BAR;
    }
    for (;;) {
        const bool has_next = S.next(ui + 1, nxt);
        const char* nA = has_next ? (const char*)(nxt.g ? g.A1 : g.A) + (size_t)nxt.pm * tstep : cA; const char* nB = has_next ? (const char*)(nxt.g ? g.Bt1 : g.Bt) + (size_t)nxt.pn * tstep : cB;
        for (int t = 0; t < nt; t += 2) {
            const bool last = (t == nt - 2);
            const char* a1 = cA + (size_t)(t + 1) * kstep;
            const char* a2 = last ? nA : cA + (size_t)(t + 2) * kstep; const char* b2 = last ? nB : cB + (size_t)(t + 2) * kstep;
            const char* a3 = a2 + kstep; const char* b3 = b2 + kstep;
            if (last && has_next) S.a_ready(nxt);
            if constexpr (SP2) {
            PG8_LDB(B0, 0, 0); PG8_LDB(B1, 0, 1); PG8_SCHED; PG8_LDA(At, 0, 0); PG8_STAGE(PG8_SA(1, 1), a1 + hstep, voffA);
            PG8_WAIT_V(8); PG8_WAIT_L(0); PG8_BAR; PG8_MMA(0, 0, At, B0); PG8_MMA(0, 1, At, B1); PG8_BAR; PG8_SCHED;
            PG8_LDA(At, 0, 1); PG8_STAGE(PG8_SB(0, 0), b2, voffB); PG8_STAGE(PG8_SB(0, 1), b2 + hstep, voffB); PG8_STAGE(PG8_SA(0, 0), a2, voffA);
            PG8_WAIT_V(8); PG8_WAIT_L(0); PG8_BAR; PG8_MMA(1, 0, At, B0); PG8_MMA(1, 1, At, B1); PG8_BAR; PG8_SCHED;
            PG8_LDB(B0, 1, 0); PG8_LDB(B1, 1, 1); PG8_SCHED; PG8_LDA(At, 1, 0); PG8_STAGE(PG8_SA(0, 1), a2 + hstep, voffA);
            PG8_WAIT_V(8); PG8_WAIT_L(0); PG8_BAR; PG8_MMA(0, 0, At, B0); PG8_MMA(0, 1, At, B1); PG8_BAR; PG8_SCHED;
            PG8_LDA(At, 1, 1); PG8_STAGE(PG8_SB(1, 0), b3, voffB); PG8_STAGE(PG8_SB(1, 1), b3 + hstep, voffB); PG8_STAGE(PG8_SA(1, 0), a3, voffA);
            PG8_WAIT_V(8); PG8_WAIT_L(0); PG8_BAR; PG8_MMA(1, 0, At, B0); PG8_MMA(1, 1, At, B1); PG8_BAR; PG8_SCHED;
            } else {
            PG8_LDB(B0, 0, 0); PG8_SCHED; PG8_LDA(At, 0, 0); PG8_STAGE(PG8_SA(1, 1), a1 + hstep, voffA);
            PG8_WAIT_L(8); PG8_BAR; PG8_WAIT_L(0); PG8_MMA(0, 0, At, B0); PG8_BAR; PG8_SCHED;
            PG8_LDB(B1, 0, 1); PG8_STAGE(PG8_SB(0, 0), b2, voffB);
            PG8_BAR; PG8_WAIT_L(0); PG8_MMA(0, 1, At, B1); PG8_BAR;
            PG8_LDA(At, 0, 1); PG8_STAGE(PG8_SA(0, 0), a2, voffA);
            PG8_BAR; PG8_WAIT_L(0); PG8_MMA(1, 0, At, B0); PG8_BAR; PG8_SCHED;
            PG8_STAGE(PG8_SB(0, 1), b2 + hstep, voffB);
            PG8_WAIT_V(6); PG8_BAR; PG8_MMA(1, 1, At, B1); PG8_BAR;
            PG8_LDB(B0, 1, 0); PG8_SCHED; PG8_LDA(At, 1, 0); PG8_STAGE(PG8_SA(0, 1), a2 + hstep, voffA);
            PG8_WAIT_L(8); PG8_BAR; PG8_WAIT_L(0); PG8_MMA(0, 0, At, B0); PG8_BAR; PG8_SCHED;
            PG8_LDB(B1, 1, 1); PG8_STAGE(PG8_SB(1, 0), b3, voffB);
            PG8_BAR; PG8_WAIT_L(0); PG8_MMA(0, 1, At, B1); PG8_BAR;
            PG8_LDA(At, 1, 1); PG8_STAGE(PG8_SA(1, 0), a3, voffA);
            PG8_BAR; PG8_WAIT_L(0); PG8_MMA(1, 0, At, B0); PG8_BAR; PG8_SCHED;
            PG8_STAGE(PG8_SB(1, 1), b3 + hstep, voffB);
            PG8_WAIT_V(6); PG8_BAR; PG8_MMA(1, 1, At, B1); PG8_BAR;
            }
        }
        if constexpr (ALIGN_EPI) { if (wr == 0) PG8_BAR; }
        if constexpr (!Epi::AFTER_DRAIN) { E(acc, cur, wr, wc, fr, fq); S.done(cur); }
        if (!has_next) break;
#pragma unroll
        for (int a = 0; a < 2; ++a)
#pragma unroll
            for (int b = 0; b < 2; ++b)
#pragma unroll
                for (int m = 0; m < 4; ++m)
#pragma unroll
                    for (int n = 0; n < 2; ++n) acc[a][b][m][n] = (f32x4){0.f, 0.f, 0.f, 0.f};
        cur = nxt; cA = nA; cB = nB; ++ui;
        if constexpr (ALIGN_EPI) { if (wr == 1) PG8_BAR; }
    }
    PG8_WAIT_V(0);
    if constexpr (!ALIGN_EPI) { if (wr == 0) PG8_BAR; }
    PG8_BAR;
    if constexpr (Epi::AFTER_DRAIN) { E.fused(acc, cur, wr, wc, fr, fq, lds, wid, lane); S.done(cur); }
#undef PG8_SA
#undef PG8_SB
#undef PG8_STAGE
#undef PG8_LDA
#undef PG8_LDB
#undef PG8_MMA
#undef PG8_WAIT_V
#undef PG8_WAIT_L
#undef PG8_BAR
#undef PG8_SCHED
}
}
namespace att {
typedef unsigned short bf16_t;
using bf16x8 = __attribute__((ext_vector_type(8))) short;
using s16x4  = __attribute__((ext_vector_type(4))) short;
using f32x16 = __attribute__((ext_vector_type(16))) float;
using u32x4  = __attribute__((ext_vector_type(4))) unsigned;
#define KSWZ(row, colB) ((row) * 256 + ((colB) ^ (((row) & 7) << 4)))
#define SBAR() __builtin_amdgcn_sched_barrier(0)
constexpr float NEGV = -1e30f, THR = 8.f;
__device__ __forceinline__ int crow(int r, int hi) { return (r & 3) + 8 * (r >> 2) + 4 * hi; }
typedef float f32x2_cv __attribute__((ext_vector_type(2))); typedef __bf16 bf16x2_cv __attribute__((ext_vector_type(2)));
__device__ __forceinline__ unsigned cvtpk(float lo, float hi) { const f32x2_cv v = {lo, hi}; const bf16x2_cv b = __builtin_convertvector(v, bf16x2_cv); return __builtin_bit_cast(unsigned, b); }
template <int DQK> struct Cfg { static constexpr float SCALE = (DQK == 96) ? 0.10206207261596577f : 0.125f; };

template <int DQK> __device__ __forceinline__ void partialSM(f32x16& p0, f32x16& p1, float& m_reg, float& mn, float& alpha) {
  constexpr float SCALE = Cfg<DQK>::SCALE, C = SCALE * 1.4426950408889634f;
  float pmax = p0[0];
#pragma unroll
  for (int r = 1; r < 16; ++r) pmax = fmaxf(pmax, p0[r]);
#pragma unroll
  for (int r = 0; r < 16; ++r) pmax = fmaxf(pmax, p1[r]);
  { auto rr = __builtin_amdgcn_permlane32_swap(__float_as_uint(pmax), __float_as_uint(pmax), false, false);
    pmax = fmaxf(__uint_as_float(rr[0]), __uint_as_float(rr[1])); }
  if (__builtin_expect(__all(pmax - m_reg <= THR / SCALE), 1)) { mn = m_reg; alpha = 1.f; }
  else { mn = fmaxf(m_reg, pmax); alpha = __builtin_amdgcn_exp2f((m_reg - mn) * C); m_reg = mn; }
  const float mnC = -mn * C;
#pragma unroll
  for (int r = 0; r < 16; ++r) p0[r] = fmaf(p0[r], C, mnC);
#pragma unroll
  for (int r = 0; r < 16; ++r) p1[r] = fmaf(p1[r], C, mnC);
#pragma unroll
  for (int r = 0; r < 16; ++r) p0[r] = __builtin_amdgcn_exp2f(p0[r]);
}
__device__ __forceinline__ void finishSM(f32x16& p0, f32x16& p1, float alpha, float& l_reg, bf16x8& pa0, bf16x8& pa1, bf16x8& pa2, bf16x8& pa3) {
#pragma unroll
  for (int r = 0; r < 16; ++r) p1[r] = __builtin_amdgcn_exp2f(p1[r]);
  float ps = 0;
#pragma unroll
  for (int r = 0; r < 16; ++r) ps += p0[r];
#pragma unroll
  for (int r = 0; r < 16; ++r) ps += p1[r];
  { auto rr = __builtin_amdgcn_permlane32_swap(__float_as_uint(ps), __float_as_uint(ps), false, false);
    ps = __uint_as_float(rr[0]) + __uint_as_float(rr[1]); }
  l_reg = l_reg * alpha + ps;
#define PK4(P, BASE, OUT) do { unsigned a0 = cvtpk(P[BASE + 0], P[BASE + 1]), a1 = cvtpk(P[BASE + 2], P[BASE + 3]);   \
    unsigned b0 = cvtpk(P[BASE + 4], P[BASE + 5]), b1 = cvtpk(P[BASE + 6], P[BASE + 7]);                              \
    auto r0 = __builtin_amdgcn_permlane32_swap(a0, b0, false, false); auto r1 = __builtin_amdgcn_permlane32_swap(a1, b1, false, false); \
    u32x4 w = {r0[0], r1[0], r0[1], r1[1]}; OUT = *reinterpret_cast<bf16x8*>(&w); } while (0)
  PK4(p0, 0, pa0); PK4(p0, 8, pa1); PK4(p1, 0, pa2); PK4(p1, 8, pa3);
#undef PK4
}
template <int DQK> __device__ __forceinline__ void qkt(f32x16& p0, f32x16& p1, const char* Ks, const bf16x8* qr, int r32, int hi) {
  p0 = f32x16{}; p1 = f32x16{};
#pragma unroll
  for (int d0 = 0; d0 < DQK / 16; ++d0) { const int cb = (d0 * 16 + hi * 8) * 2;
    const bf16x8 b0 = *reinterpret_cast<const bf16x8*>(Ks + KSWZ(r32, cb));
    const bf16x8 b1 = *reinterpret_cast<const bf16x8*>(Ks + KSWZ(32 + r32, cb));
    p0 = __builtin_amdgcn_mfma_f32_32x32x16_bf16(b0, qr[d0], p0, 0, 0, 0);
    p1 = __builtin_amdgcn_mfma_f32_32x32x16_bf16(b1, qr[d0], p1, 0, 0, 0); }
}
__device__ __forceinline__ int v_st(int k, int c) { const int kk = (k & ~0xC) | ((k & 4) << 1) | ((k & 8) >> 1); return ((kk >> 3) * 4 + (c >> 5)) * 512 + ((kk & 7) * 32 + (c & 31)) * 2; }
__device__ __forceinline__ int v_rd_base(int lane) { return ((lane & 3) << 3) | (((lane >> 2) & 3) << 6) | (((lane >> 4) & 1) << 5) | (((lane >> 5) & 1) << 8); }
constexpr int v_rd_off(int d0, int ks, int half) { return d0 * 512 + ks * 4096 + half * 2048; }
template <int OFF> __device__ __forceinline__ s16x4 tr_read(int vb) {
  s16x4 r; asm volatile("ds_read_b64_tr_b16 %0, %1 offset:%2" : "=&v"(r) : "v"(vb), "i"(OFF) : "memory"); return r;
}
template <int D0> __device__ __forceinline__ void pv_one(f32x16& od, int vb, bf16x8 pa0, bf16x8 pa1, bf16x8 pa2, bf16x8 pa3) {
  const s16x4 l0 = tr_read<v_rd_off(D0, 0, 0)>(vb), h0 = tr_read<v_rd_off(D0, 0, 1)>(vb), l1 = tr_read<v_rd_off(D0, 1, 0)>(vb), h1 = tr_read<v_rd_off(D0, 1, 1)>(vb);
  const s16x4 l2 = tr_read<v_rd_off(D0, 2, 0)>(vb), h2 = tr_read<v_rd_off(D0, 2, 1)>(vb), l3 = tr_read<v_rd_off(D0, 3, 0)>(vb), h3 = tr_read<v_rd_off(D0, 3, 1)>(vb);
  asm volatile("s_waitcnt lgkmcnt(0)" ::: "memory"); SBAR();
#define PK(L, H) (bf16x8){L[0], L[1], L[2], L[3], H[0], H[1], H[2], H[3]}
  od = __builtin_amdgcn_mfma_f32_32x32x16_bf16(pa0, PK(l0, h0), od, 0, 0, 0);
  od = __builtin_amdgcn_mfma_f32_32x32x16_bf16(pa1, PK(l1, h1), od, 0, 0, 0);
  od = __builtin_amdgcn_mfma_f32_32x32x16_bf16(pa2, PK(l2, h2), od, 0, 0, 0);
  od = __builtin_amdgcn_mfma_f32_32x32x16_bf16(pa3, PK(l3, h3), od, 0, 0, 0);
#undef PK
}
__device__ __forceinline__ void pv2(f32x16* o, int vb, bf16x8 pa0, bf16x8 pa1, bf16x8 pa2, bf16x8 pa3) {
  pv_one<0>(o[0], vb, pa0, pa1, pa2, pa3); pv_one<1>(o[1], vb, pa0, pa1, pa2, pa3);
}

template <int DQK, bool IS_NA>
__device__ __forceinline__ void attn_unit(const bf16_t* __restrict__ Qb, const bf16_t* __restrict__ Kh, const bf16_t* __restrict__ Vh, bf16_t* Ob,
                                          const int NT, const int r0, const int krow0, const int nkr, const float* __restrict__ rpbh, char* lds) {
  constexpr int LDQ = IS_NA ? 512 : 768, LDK = LDQ, LDV = 512, LDO = 512, ND = DQK / 16, NKC = DQK / 8;
  constexpr bool K2 = (NKC * 64 > 512);
  int tid_ = threadIdx.x; asm volatile("" : "+v"(tid_));
  const int tid = tid_, wid = __builtin_amdgcn_readfirstlane(tid >> 6), lane = tid & 63, r32 = lane & 31, hi = lane >> 5;
  char* V_lds = lds; char* K_lds = lds + 32768;
  float* ws = (float*)(lds + 65536) + wid * 64; float* li_l = ws; float* al_l = ws + 32;
  float* tab = (float*)(lds + 65536 + 2048);
  if constexpr (IS_NA) { for (int i = tid; i < 15 * 128; i += 512) { const int dr = i >> 7, x = (i & 127) - 48; tab[i] = (x >= 0 && x < 31) ? rpbh[dr * 31 + x] * 8.f : 0.f; } }
  const int myrow = r0 + (wid >> 1), rs = min(max(myrow - 4, 0), 56), cq = (wid & 1) * 32 + r32, lo = min(max(cq - 8, 0), 48);
  float m_reg = -1e30f, l_reg = 0; f32x16 o[2]; o[0] = f32x16{}; o[1] = f32x16{}; bf16x8 qr[ND];
  const bf16_t* Qw = Qb + (size_t)(wid * 32 + r32) * LDQ + hi * 8;
#pragma unroll
  for (int d0 = 0; d0 < ND; ++d0) qr[d0] = *reinterpret_cast<const bf16x8*>(Qw + d0 * 16);
  const int kr0 = tid / NKC, kc0 = tid % NKC;
  const int ck1 = (tid + 512 < NKC * 64) ? tid + 512 : NKC * 64 - 1; const int kr1 = ck1 / NKC, kc1 = ck1 % NKC; const bool k1on = (tid + 512) < NKC * 64;
  const int vr = tid >> 3, vc = (tid & 7) * 8;
  const int vst = v_st(vr, vc), kst0 = KSWZ(kr0, kc0 * 16), kst1 = KSWZ(kr1, kc1 * 16);
  const int vb0 = (int)(uintptr_t)V_lds + v_rd_base(lane);
  struct { bf16x8 vs0, ks0, ks1; } sr_[2];
#define KEYBASE(j) (IS_NA ? ((j) == 0 ? 0 : 16 + 64 * min(krow0 + (j) - 1, krow0 + nkr - 1)) : 64 * (j))
#define SLOAD(i, j) do { const int kb_ = KEYBASE(j); sr_[i].ks0 = *reinterpret_cast<const bf16x8*>(Kh + (size_t)(kb_ + kr0) * LDK + kc0 * 8); \
    if (K2) sr_[i].ks1 = *reinterpret_cast<const bf16x8*>(Kh + (size_t)(kb_ + kr1) * LDK + kc1 * 8); \
    sr_[i].vs0 = *reinterpret_cast<const bf16x8*>(Vh + (size_t)(kb_ + vr) * LDV + vc); } while (0)
#define SWRITE(b, i) do { *(bf16x8*)(K_lds + (b) * 16384 + kst0) = sr_[i].ks0; if (K2 && k1on) *(bf16x8*)(K_lds + (b) * 16384 + kst1) = sr_[i].ks1; \
    *(bf16x8*)(V_lds + (b) * 16384 + vst) = sr_[i].vs0; } while (0)
#define SWAIT() do { if (K2) asm volatile("s_waitcnt vmcnt(3)" ::: "memory"); else asm volatile("s_waitcnt vmcnt(2)" ::: "memory"); } while (0)
#define RESC(a) do { if (__any((a) < 1.f)) { if (hi == 0) al_l[r32] = (a); asm volatile("s_waitcnt lgkmcnt(0)" ::: "memory"); \
    _Pragma("unroll") for (int d = 0; d < 2; ++d) _Pragma("unroll") for (int r = 0; r < 16; ++r) o[d][r] *= al_l[crow(r, hi)]; } } while (0)
#define MASK(P0, P1, j) do { \
    if (!IS_NA) { if ((j) >= 64) { const int kb_ = 64 * (j) + 4 * hi; \
        _Pragma("unroll") for (int r = 0; r < 16; ++r) { const int kv = kb_ + (r & 3) + 8 * (r >> 2); if (kv >= 4112) P0[r] = NEGV; if (kv + 32 >= 4112) P1[r] = NEGV; } } } \
    else if ((j) == 0) { _Pragma("unroll") for (int r = 0; r < 16; ++r) { const int kc = (r & 3) + 8 * (r >> 2) + 4 * hi; if (kc >= 16) P0[r] = NEGV; P1[r] = NEGV; } } \
    else { const int kr_ = krow0 + (j) - 1; const bool ok_ = ((j) - 1 < nkr) && (kr_ >= rs) && (kr_ < rs + 8); \
      if (!ok_) { _Pragma("unroll") for (int r = 0; r < 16; ++r) { P0[r] = NEGV; P1[r] = NEGV; } } \
      else { const float* tb_ = tab + (kr_ - myrow + 7) * 128 + (63 - cq) + 4 * hi; const int kl_ = 4 * hi - lo; \
        _Pragma("unroll") for (int r = 0; r < 16; ++r) { const int e = (r & 3) + 8 * (r >> 2); const float b0 = tb_[e], b1 = tb_[e + 32]; \
          P0[r] = ((unsigned)(e + kl_) < 16u) ? P0[r] + b0 : NEGV; P1[r] = ((unsigned)(e + 32 + kl_) < 16u) ? P1[r] + b1 : NEGV; } } } \
  } while (0)
  f32x16 pA0, pA1, pB0, pB1; float mnA, mnB, alA, alB; bf16x8 pa0, pa1, pa2, pa3;
  constexpr int SE = 0, SO = 1;
  SLOAD(SE, 0); asm volatile("s_waitcnt vmcnt(0)" ::: "memory"); SWRITE(0, SE); __syncthreads();
  qkt<DQK>(pA0, pA1, K_lds, qr, r32, hi); MASK(pA0, pA1, 0); partialSM<DQK>(pA0, pA1, m_reg, mnA, alA);
  SLOAD(SO, 1); if (2 < NT) SLOAD(SE, 2);
  SWAIT(); SWRITE(1, SO); __syncthreads();
  for (int j = 1; j + 1 < NT; j += 2) {
    SBAR(); qkt<DQK>(pB0, pB1, K_lds + 16384, qr, r32, hi);
    finishSM(pA0, pA1, alA, l_reg, pa0, pa1, pa2, pa3); SBAR();
    SLOAD(SO, j + 2); SBAR();
    pv2(o, vb0, pa0, pa1, pa2, pa3); MASK(pB0, pB1, j); partialSM<DQK>(pB0, pB1, m_reg, mnB, alB);
    __syncthreads(); SWAIT(); SWRITE(0, SE);
    RESC(alB); __syncthreads();
    SBAR(); qkt<DQK>(pA0, pA1, K_lds, qr, r32, hi);
    finishSM(pB0, pB1, alB, l_reg, pa0, pa1, pa2, pa3); SBAR();
    if (j + 3 < NT) SLOAD(SE, j + 3); SBAR();
    pv2(o, vb0 + 16384, pa0, pa1, pa2, pa3); MASK(pA0, pA1, j + 1); partialSM<DQK>(pA0, pA1, m_reg, mnA, alA);
    __syncthreads(); SWAIT(); SWRITE(1, SO);
    RESC(alA); __syncthreads();
  }
  SBAR(); qkt<DQK>(pB0, pB1, K_lds + 16384, qr, r32, hi);
  finishSM(pA0, pA1, alA, l_reg, pa0, pa1, pa2, pa3); SBAR();
  pv2(o, vb0, pa0, pa1, pa2, pa3); MASK(pB0, pB1, NT - 1); partialSM<DQK>(pB0, pB1, m_reg, mnB, alB);
  __syncthreads(); RESC(alB);
  finishSM(pB0, pB1, alB, l_reg, pa0, pa1, pa2, pa3); SBAR();
  pv2(o, vb0 + 16384, pa0, pa1, pa2, pa3);
  if (hi == 0) li_l[r32] = l_reg; asm volatile("s_waitcnt lgkmcnt(0)" ::: "memory");
  float rli[16];
#pragma unroll
  for (int r = 0; r < 16; ++r) rli[r] = __builtin_amdgcn_rcpf(li_l[crow(r, hi)]);
  bf16_t* Ow = Ob + (size_t)(wid * 32) * LDO;
#pragma unroll
  for (int r = 0; r < 16; ++r) { const int orow = crow(r, hi);
#pragma unroll
    for (int d0 = 0; d0 < 2; ++d0) Ow[(size_t)orow * LDO + d0 * 32 + r32] = (bf16_t)(cvtpk(o[d0][r] * rli[r], 0.f) & 0xffffu); }
  __syncthreads();
#undef KEYBASE
#undef SLOAD
#undef SWRITE
#undef SWAIT
#undef RESC
#undef MASK
}
#undef KSWZ
#undef SBAR
}
namespace cg = cooperative_groups;
#define LAS __attribute__((address_space(3)))
typedef unsigned short bf16;
typedef unsigned v4u __attribute__((ext_vector_type(4)));
typedef float f32x4 __attribute__((ext_vector_type(4)));
__device__ __forceinline__ unsigned f2bf(float f) { unsigned u = __builtin_bit_cast(unsigned, f); return (u + 0x7fffu + ((u >> 16) & 1u)) >> 16; }
__device__ __forceinline__ unsigned pk2(float lo, float hi) { return f2bf(lo) | (f2bf(hi) << 16); }
__device__ __forceinline__ float wave_sum(float v) {
#pragma unroll
    for (int o = 1; o < 64; o <<= 1) v += __shfl_xor(v, o);
    return v;
}
#define LDS_WAIT() asm volatile("s_waitcnt lgkmcnt(0)" ::: "memory")
__device__ __forceinline__ int pperm(int d) { return d < 16 ? 8 * (d >> 2) + (d & 3) : 8 * ((d - 16) >> 2) + 4 + (d & 3); }
__device__ __forceinline__ int dstcol(int mat, int n) {
    if (mat == 0) { if (n < 1536) return n; if (n < 1920) return n - 1536 + 3840; if (n < 2176) return n - 1920 + 1536; if (n < 2208) return 4224 + pperm(n - 2176); if (n < 3232) return n - 2208 + 1792; return n - 3232 + 2816; }
    if (mat == 1) { const int h = n / 96, j = n % 96; return j < 64 ? h * 64 + j : 512 + h * 32 + pperm(j - 64); }
    if (mat == 2) { const int h = n >> 7, j = n & 127; return j < 64 ? h * 64 + j : 512 + h * 64 + (j - 64); }
    return n;
}
__device__ __forceinline__ void p0_transpose_item(const float* W, int K, int N, bf16* WT, const float* gain, int mat, LAS float* scr, int item, int lane) {
    const int nblk = N / 32, kb = item / nblk, nb = item % nblk, k0 = 64 * kb, n0 = 32 * nb;
#pragma unroll 8
    for (int i = 0; i < 32; ++i) { const int kk = 2 * i + (lane >> 5); const float g = gain ? gain[k0 + kk] : 1.f; scr[kk * 33 + (lane & 31)] = W[(size_t)(k0 + kk) * N + n0 + (lane & 31)] * g; }
    LDS_WAIT(); asm volatile("" ::: "memory");
    const int c = lane & 7;
#pragma unroll
    for (int j = 0; j < 4; ++j) { const int n = (lane >> 3) + 8 * j; const LAS float* s = scr + (8 * c) * 33 + n;
        v4u o; o.x = pk2(s[0 * 33], s[1 * 33]); o.y = pk2(s[2 * 33], s[3 * 33]); o.z = pk2(s[4 * 33], s[5 * 33]); o.w = pk2(s[6 * 33], s[7 * 33]);
        *(v4u*)(WT + (size_t)dstcol(mat, n0 + n) * K + k0 + 8 * c) = o; }
    LDS_WAIT(); asm volatile("" ::: "memory");
}
__device__ __forceinline__ void rms_row_to_bf16(const float* xrow, bf16* orow, int lane) {
    const f32x4* xr = (const f32x4*)xrow + lane;
    f32x4 v[4]; float s = 0.f;
#pragma unroll
    for (int j = 0; j < 4; ++j) { v[j] = xr[64 * j]; s += (v[j].x * v[j].x + v[j].y * v[j].y) + (v[j].z * v[j].z + v[j].w * v[j].w); }
    const float rstd = 1.f / sqrtf(wave_sum(s) * (1.f / DM) + EPS);
    unsigned long long* o8 = (unsigned long long*)orow + lane;
#pragma unroll
    for (int j = 0; j < 4; ++j) o8[64 * j] = (unsigned long long)pk2(v[j].x * rstd, v[j].y * rstd) | ((unsigned long long)pk2(v[j].z * rstd, v[j].w * rstd) << 32);
}

#define XB_TMO      128
#define XB_XCNT(j)  (256  + 64 * (j))
#define XB_XSUB(j)  (1280 + 64 * (j))
#define XB_XGEN(j)  (2304 + 64 * (j))
#define XB_TOP      3328
#define XB_TOPGEN   3392
#define XCD_BAR_WORDS 3456
#define XB_SPIN_CAP (1u << 18)

__device__ __forceinline__ unsigned xb_ld(unsigned* p)              { return __hip_atomic_load(p, __ATOMIC_RELAXED, __HIP_MEMORY_SCOPE_AGENT); }
__device__ __forceinline__ unsigned xb_add(unsigned* p, unsigned v) { return __hip_atomic_fetch_add(p, v, __ATOMIC_RELAXED, __HIP_MEMORY_SCOPE_AGENT); }
__device__ __forceinline__ unsigned xb_xcc_id() { return (unsigned)__builtin_amdgcn_s_getreg((3 << 11) | 20) & 0xFu; }
#define XB_SPIN(cond, bar) do { unsigned _sp = 0; while (cond) { __builtin_amdgcn_s_sleep(1); \
    if ((++_sp & 255u) == 0u) { if (xb_ld(&(bar)[XB_TMO])) break; if (_sp > XB_SPIN_CAP) { atomicAdd(&(bar)[XB_TMO], 1u); break; } } } } while (0)

struct XcdBarrier {
    unsigned* bar; unsigned x;
    volatile LAS unsigned* st;
};

__device__ __forceinline__ XcdBarrier xcd_barrier_post(unsigned* bar, volatile LAS unsigned* st) {
    XcdBarrier b; b.bar = bar; b.x = xb_xcc_id(); b.st = st;
    if (threadIdx.x == 0) (void)xb_add(&bar[XB_XCNT(b.x)], 1u);
    return b;
}
__device__ __forceinline__ void xcd_barrier_complete(unsigned* bar, unsigned x, unsigned& nloc, unsigned& nx) {
    const unsigned G = gridDim.x * gridDim.y * gridDim.z;
    unsigned sum, cnt, mine, sp = 0u;
    for (;;) {
        sum = 0u; cnt = 0u; mine = 0u;
#pragma unroll
        for (unsigned j = 0; j < 16; ++j) { const unsigned c = xb_ld(&bar[XB_XCNT(j)]); sum += c; cnt += (c > 0u) ? 1u : 0u; mine = (j == x) ? c : mine; }
        if (sum == G) break;
        __builtin_amdgcn_s_sleep(1);
        if ((++sp & 255u) == 0u) { if (xb_ld(&bar[XB_TMO])) break; if (sp > XB_SPIN_CAP) { atomicAdd(&bar[XB_TMO], 1u); break; } }
    }
    nloc = mine > 0u ? mine : 1u; nx = cnt > 0u ? cnt : 1u;
}

__device__ __forceinline__ void xcd_barrier(const XcdBarrier& b) {
    asm volatile("s_waitcnt vmcnt(0)" ::: "memory");
    __syncthreads();
    if (threadIdx.x == 0) {
        unsigned* bar = b.bar;
        __builtin_amdgcn_s_waitcnt(0);
        unsigned nloc = b.st[0], nx = b.st[1];
        if (nloc == 0u) { xcd_barrier_complete(bar, b.x, nloc, nx); b.st[0] = nloc; b.st[1] = nx; }
        const unsigned old = xb_add(&bar[XB_XSUB(b.x)], 1u);
        const unsigned gen = old / nloc;
        if (old + 1u == (gen + 1u) * nloc) {
            __builtin_amdgcn_fence(__ATOMIC_RELEASE, "agent");
            asm volatile("s_waitcnt vmcnt(0)" ::: "memory");
            const unsigned og = xb_add(&bar[XB_TOP], 1u);
            const unsigned tg = og / nx;
            if (og + 1u == (tg + 1u) * nx) xb_add(&bar[XB_TOPGEN], 1u);
            else XB_SPIN(xb_ld(&bar[XB_TOPGEN]) == tg, bar);
            __builtin_amdgcn_fence(__ATOMIC_ACQUIRE, "agent");
            xb_add(&bar[XB_XGEN(b.x)], 1u);
            asm volatile("s_waitcnt vmcnt(0)" ::: "memory");
        } else {
            XB_SPIN(xb_ld(&bar[XB_XGEN(b.x)]) == gen, bar);
            __builtin_amdgcn_fence(__ATOMIC_ACQUIRE, "agent");
            asm volatile("s_waitcnt vmcnt(0)" ::: "memory");
        }
    }
    __syncthreads();
}

struct Args { const float* in[16]; float* out; unsigned char* ws; };

__device__ __forceinline__ void meta_part1(const float* meta, const float* norm_mix, const float* w_in, float* MP, LAS float* L, int ci, int tid) {
    const int wave = tid >> 6, lane = tid & 63;
    for (int j = wave; j < 16; j += 8) {
        float x[16]; float s = 0.f;
#pragma unroll
        for (int i = 0; i < 16; ++i) { x[i] = meta[j * 1024 + lane + 64 * i]; s += x[i] * x[i]; }
        const float rstd = 1.f / sqrtf(wave_sum(s) * (1.f / 1024.f) + EPS);
#pragma unroll
        for (int i = 0; i < 16; ++i) L[j * 1024 + lane + 64 * i] = x[i] * rstd * norm_mix[lane + 64 * i];
    }
    __syncthreads();
    const int n0 = ci < 32 ? 512 + 32 * ci : 1920 + 32 * (ci - 32);
    const int col = lane & 31, part = wave * 2 + (lane >> 5), kb = part * 64;
    float acc[16];
#pragma unroll
    for (int j = 0; j < 16; ++j) acc[j] = 0.f;
    for (int k = kb; k < kb + 64; k += 4) {
        const float w0 = w_in[(size_t)k * D_IN + n0 + col], w1 = w_in[(size_t)(k + 1) * D_IN + n0 + col], w2 = w_in[(size_t)(k + 2) * D_IN + n0 + col], w3 = w_in[(size_t)(k + 3) * D_IN + n0 + col];
#pragma unroll
        for (int j = 0; j < 16; ++j) { const f32x4 h = *(const LAS f32x4*)(L + j * 1024 + k); acc[j] += (h.x * w0 + h.y * w1) + (h.z * w2 + h.w * w3); }
    }
#pragma unroll
    for (int j = 0; j < 16; ++j) L[16384 + (part * 16 + j) * 32 + col] = acc[j];
    __syncthreads();
    { const int j = tid >> 5, c = tid & 31; float s = 0.f;
#pragma unroll
      for (int p = 0; p < 16; ++p) s += L[16384 + (p * 16 + j) * 32 + c];
      MP[j * 1312 + 32 * ci + c] = s; }
    __syncthreads();
}
__device__ __forceinline__ void meta_part2(const float* MP, const float* kvn, const float* w_ukv, const float* rope, bf16* KNA, bf16* VNA, bf16* KM, bf16* VM, LAS float* L, int tid) {
    const int wave = tid >> 6, lane = tid & 63;
    for (int idx = tid; idx < 16 * 1024; idx += 512) { const int j = idx >> 10, c = idx & 1023; const bf16 v = (bf16)f2bf(MP[j * 1312 + c]); bf16* dst = c < 512 ? KNA : VNA;
#pragma unroll
        for (int b = 0; b < BATCH; ++b) dst[(size_t)(b * KPB + j) * 512 + (c & 511)] = v; }
    for (int j = wave; j < 16; j += 8) {
        float x[4]; float s = 0.f;
#pragma unroll
        for (int i = 0; i < 4; ++i) { x[i] = MP[j * 1312 + 1024 + lane + 64 * i]; s += x[i] * x[i]; }
        const float rstd = 1.f / sqrtf(wave_sum(s) * (1.f / 256.f) + EPS);
#pragma unroll
        for (int i = 0; i < 4; ++i) L[j * 256 + lane + 64 * i] = x[i] * rstd * kvn[lane + 64 * i];
    }
    __syncthreads();
    for (int q = 0; q < 4; ++q) {
        const int n0 = (wave * 4 + q) * 32, col = lane & 31, half = lane >> 5;
        float acc[16];
#pragma unroll
        for (int j = 0; j < 16; ++j) acc[j] = 0.f;
        for (int k = half * 128; k < half * 128 + 128; k += 4) {
            const float w0 = w_ukv[(size_t)k * 1024 + n0 + col], w1 = w_ukv[(size_t)(k + 1) * 1024 + n0 + col], w2 = w_ukv[(size_t)(k + 2) * 1024 + n0 + col], w3 = w_ukv[(size_t)(k + 3) * 1024 + n0 + col];
#pragma unroll
            for (int j = 0; j < 16; ++j) { const f32x4 h = *(const LAS f32x4*)(L + j * 256 + k); acc[j] += (h.x * w0 + h.y * w1) + (h.z * w2 + h.w * w3); }
        }
#pragma unroll
        for (int j = 0; j < 16; ++j) acc[j] += __shfl_xor(acc[j], 32);
        if (half == 0) { const int n = n0 + col, h = n >> 7, jj = n & 127;
#pragma unroll
            for (int j = 0; j < 16; ++j) { const bf16 v = (bf16)f2bf(acc[j]);
#pragma unroll
                for (int b = 0; b < BATCH; ++b) { if (jj < 64) KM[(size_t)(b * KPB + j) * 768 + h * 96 + jj] = v; else VM[(size_t)(b * KPB + j) * 512 + h * 64 + (jj - 64)] = v; } } }
    }
    if (tid < 256) { const int j = tid >> 4, i = tid & 15; const float x1 = MP[j * 1312 + 1280 + i], x2 = MP[j * 1312 + 1296 + i], c = rope[(j * 16 + i) * 2], s = rope[(j * 16 + i) * 2 + 1];
        const bf16 o1 = (bf16)f2bf(x1 * c - x2 * s), o2 = (bf16)f2bf(x2 * c + x1 * s); const int p1 = pperm(i), p2 = pperm(16 + i);
        for (int b = 0; b < BATCH; ++b) for (int h = 0; h < 8; ++h) { KM[(size_t)(b * KPB + j) * 768 + h * 96 + 64 + p1] = o1; KM[(size_t)(b * KPB + j) * 768 + h * 96 + 64 + p2] = o2; } }
    __syncthreads();
}


#define GRID_SYNC() do { asm volatile("s_waitcnt vmcnt(0)" ::: "memory"); grid.sync(); \
    if (wave == 0) { __builtin_amdgcn_fence(__ATOMIC_ACQUIRE, "agent"); asm volatile("s_waitcnt vmcnt(0)" ::: "memory"); } __syncthreads(); } while (0)
#define XCD_SYNC() xcd_barrier(xbar)
__global__ void __launch_bounds__(NWAVES * 64, 2) mega_fwd(Args a) {
    extern __shared__ __attribute__((aligned(16))) unsigned char lds[];
    cg::grid_group grid = cg::this_grid();
    LAS unsigned char* L3 = (LAS unsigned char*)lds;
    const int tid = threadIdx.x, lane = tid & 63, wave = __builtin_amdgcn_readfirstlane(tid >> 6);
    const int G = gridDim.x, bx = blockIdx.x; const int vcu = (G % 8 == 0) ? (bx % 8) * (G / 8) + bx / 8 : bx;
    unsigned char* ws = a.ws;
    if (tid < 16) ((LAS unsigned*)(L3 + 131072 + 64))[tid] = 0u;
    __syncthreads();
    const XcdBarrier xbar = xcd_barrier_post((unsigned*)(ws + WS_BAR), (volatile LAS unsigned*)(L3 + 131072 + 64));
    const float *x = a.in[0], *meta = a.in[1], *norm_mix = a.in[2], *w_in = a.in[3], *na_rpb = a.in[4], *q_norm = a.in[5], *w_uq = a.in[6], *kv_norm = a.in[7], *w_ukv = a.in[8],
                *w_na_out = a.in[9], *w_mla_out = a.in[10], *w_out = a.in[11], *norm_ffn = a.in[12], *w_ff1 = a.in[13], *w_ff2 = a.in[14], *norm_final = a.in[15];
    float* out = a.out;
    float* ROPE = (float*)(ws + WS_ROPE); float* MP = (float*)(ws + WS_MP);
    bf16 *Win_t = (bf16*)(ws + WS_WIN), *Wuq_t = (bf16*)(ws + WS_WUQ), *Wukv_t = (bf16*)(ws + WS_WUKV), *Wna_t = (bf16*)(ws + WS_WNA), *Wmla_t = (bf16*)(ws + WS_WMLA), *Wout_t = (bf16*)(ws + WS_WOUT),
         *Wff1_t = (bf16*)(ws + WS_WFF1), *Wff2_t = (bf16*)(ws + WS_WFF2);
    bf16 *HN = (bf16*)(ws + WS_HN), *QM = (bf16*)(ws + WS_QM), *MG = (bf16*)(ws + WS_MG), *QNA = (bf16*)(ws + WS_QNA), *H2B = (bf16*)(ws + WS_H2B), *KNA = (bf16*)(ws + WS_KNA), *VNA = (bf16*)(ws + WS_VNA),
         *CQ = (bf16*)((unsigned char*)a.out + DO_CQ), *CKV = (bf16*)((unsigned char*)a.out + DO_CKV), *ONA = (bf16*)((unsigned char*)a.out + DO_ONA), *TB = (bf16*)((unsigned char*)a.out + DO_T), *KM = (bf16*)(ws + WS_KM), *VM = (bf16*)(ws + WS_VM), *GNA = (bf16*)(ws + WS_GNA), *GMLA = (bf16*)(ws + WS_GMLA), *OMLA = (bf16*)((unsigned char*)a.out + DO_OMLA), *U = (bf16*)(ws + WS_U);
    float *SSQ_CKV = (float*)(ws + WS_SSQ_CKV), *SSQ_CQ = (float*)(ws + WS_SSQ_CQ), *SSQ_H2 = (float*)(ws + WS_SSQ_H2), *SSQ_H3 = (float*)(ws + WS_SSQ_H3);

#ifndef NO_P0
    {
        for (int ci = bx; ci < 41; ci += G) meta_part1(meta, norm_mix, w_in, MP, (LAS float*)L3, ci, tid);
        LAS float* scr = (LAS float*)(L3 + wave * 16384);
        const int gw = vcu * NWAVES + wave, NGW = G * NWAVES;
        constexpr int I_IN = (DM / 64) * (D_IN / 32), I_UQ = (384 / 64) * (768 / 32), I_UKV = (256 / 64) * (1024 / 32), I_NA = (512 / 64) * (1024 / 32), I_OUT = (DM / 64) * (DM / 32),
                      I_F1 = (DM / 64) * (FF / 32), I_F2 = (FF / 64) * (DM / 32), NITEMS = I_IN + I_UQ + I_UKV + 2 * I_NA + I_OUT + I_F1 + I_F2;
        for (int it = gw; it < NITEMS; it += NGW) {
            int r = it;
            if (r < I_IN) { p0_transpose_item(w_in, DM, D_IN, Win_t, norm_mix, 0, scr, r, lane); continue; } r -= I_IN;
            if (r < I_UQ) { p0_transpose_item(w_uq, 384, 768, Wuq_t, q_norm, 1, scr, r, lane); continue; } r -= I_UQ;
            if (r < I_UKV) { p0_transpose_item(w_ukv, 256, 1024, Wukv_t, kv_norm, 2, scr, r, lane); continue; } r -= I_UKV;
            if (r < I_NA) { p0_transpose_item(w_na_out, 512, 1024, Wna_t, nullptr, 3, scr, r, lane); continue; } r -= I_NA;
            if (r < I_NA) { p0_transpose_item(w_mla_out, 512, 1024, Wmla_t, nullptr, 3, scr, r, lane); continue; } r -= I_NA;
            if (r < I_OUT) { p0_transpose_item(w_out, DM, DM, Wout_t, nullptr, 3, scr, r, lane); continue; } r -= I_OUT;
            if (r < I_F1) { p0_transpose_item(w_ff1, DM, FF, Wff1_t, norm_ffn, 3, scr, r, lane); continue; } r -= I_F1;
            p0_transpose_item(w_ff2, FF, DM, Wff2_t, nullptr, 3, scr, r, lane);
        }
        for (int m = gw; m < M; m += NGW) rms_row_to_bf16(x + (size_t)m * DM, HN + (size_t)m * DM, lane);
        const int gt = bx * (NWAVES * 64) + tid, NGT = G * NWAVES * 64;
        for (int e = gt; e < LTOT * 16; e += NGT) {
            const int pos = e >> 4, i = e & 15;
            const float inv = __builtin_amdgcn_exp2f(-(float)i * (13.287712379549449f / 16.0f));
            const float ang = (float)pos * inv;
            double rev = (double)ang * 0.15915494309189535; rev -= __builtin_rint(rev);
            const float rv = (float)rev;
            ROPE[2 * e] = __builtin_amdgcn_cosf(rv); ROPE[2 * e + 1] = __builtin_amdgcn_sinf(rv);
        }
        const v4u z = {0u, 0u, 0u, 0u};
        for (int e = gt; e < 96 * 128; e += NGT) *(v4u*)(Win_t + (size_t)D_IN * DM + (size_t)e * 8) = z;
        for (int e = gt; e < BATCH * 112 * 288; e += NGT) {
            const int c = e % 288, rr = e / 288, b = rr / 112, kr = LTOT + rr % 112; const size_t row = (size_t)b * KPB + kr;
            if (c < 64) *(v4u*)(KNA + row * 512 + c * 8) = z; else if (c < 128) *(v4u*)(VNA + row * 512 + (c - 64) * 8) = z;
            else if (c < 224) *(v4u*)(KM + row * 768 + (c - 128) * 8) = z; else *(v4u*)(VM + row * 512 + (c - 224) * 8) = z;
        }
    }
#endif
    GRID_SYNC();
#ifndef NO_P1
    {
        if (bx == G - 1) meta_part2(MP, kv_norm, w_ukv, ROPE, KNA, VNA, KM, VM, (LAS float*)L3, tid);
        pg8::Gemm g{HN, Win_t, nullptr, nullptr, M, N_IN, DM}; pg8::StaticOrder S; S.init(M, N_IN, G, bx);
        pg8::EpiP1 E{ws, CKV, CQ, KM, SSQ_CKV, SSQ_CQ, ROPE};
        pg8::gemm_phase<pg8::EpiP1, pg8::StaticOrder, true, true>(L3, g, S, E);
    }
#endif
    XCD_SYNC();
#ifndef NO_P2
    {
#ifndef NO_P2A
        { pg8::Gemm g{CQ, Wuq_t, nullptr, nullptr, M, 768, 384}; pg8::StaticOrder S; S.init(M, 768, G, bx);
          pg8::EpiP2Q E{QM, SSQ_CQ, ROPE};
          pg8::gemm_phase<pg8::EpiP2Q, pg8::StaticOrder, false, true>(L3, g, S, E); }
#endif
        __syncthreads();
#ifndef NO_P2B
        { pg8::Gemm g{CKV, Wukv_t, nullptr, nullptr, M, 1024, 256}; pg8::StaticOrder S; S.init(M, 1024, G, bx);
          pg8::EpiP2KV E{KM, VM, SSQ_CKV};
          pg8::gemm_phase<pg8::EpiP2KV, pg8::StaticOrder, false, true>(L3, g, S, E); }
#endif
    }
#endif
    XCD_SYNC();
#ifndef NO_P3
    {
        for (int u = vcu; u < 1024; u += G) {
            if (u < 512) { const int bh = u >> 4, qb = u & 15, b = bh >> 3, h = bh & 7;
                att::attn_unit<96, false>(QM + (size_t)(b * SEQ + 256 * qb) * 768 + h * 96, KM + (size_t)b * KPB * 768 + h * 96, VM + (size_t)b * KPB * 512 + h * 64,
                                          OMLA + (size_t)(b * SEQ + 256 * qb) * 512 + h * 64, 66, 0, 0, 0, nullptr, (char*)lds);
            } else { const int v = u - 512, bh = v >> 4, rg = v & 15, b = bh >> 3, h = bh & 7, r0 = 4 * rg;
                const int krow0 = min(max(r0 - 4, 0), 56), klast = min(max(r0 + 3 - 4, 0), 56) + 7, nkr = klast - krow0 + 1; const int NT = (1 + nkr + 1) & ~1;
                att::attn_unit<64, true>(QNA + (size_t)(b * SEQ + 256 * rg) * 512 + h * 64, KNA + (size_t)b * KPB * 512 + h * 64, VNA + (size_t)b * KPB * 512 + h * 64,
                                         ONA + (size_t)(b * SEQ + 256 * rg) * 512 + h * 64, NT, r0, krow0, nkr, na_rpb + h * 15 * 31, (char*)lds);
            }
        }
    }
#endif
    XCD_SYNC();
#ifndef NO_P4
    {
        pg8::Gemm g{ONA, Wna_t, nullptr, nullptr, M, DM, 512}; pg8::StaticOrder S; S.init(M, DM, G, bx);
        pg8::EpiP4 E{ws, TB, MG, 0};
        pg8::gemm_phase<pg8::EpiP4, pg8::StaticOrder, false, true>(L3, g, S, E);
    }
    XCD_SYNC();
    {
        pg8::Gemm g{OMLA, Wmla_t, nullptr, nullptr, M, DM, 512}; pg8::StaticOrder S; S.init(M, DM, G, bx);
        pg8::EpiP4 E{ws, TB, MG, 1};
        pg8::gemm_phase<pg8::EpiP4, pg8::StaticOrder, false, true>(L3, g, S, E);
    }
#endif
    XCD_SYNC();
#ifndef NO_P5
    {
        pg8::Gemm g{MG, Wout_t, nullptr, nullptr, M, DM, DM}; pg8::StaticOrder S; S.init(M, DM, G, bx);
        pg8::EpiP5 E{x, out, H2B, SSQ_H2};
        pg8::gemm_phase<pg8::EpiP5, pg8::StaticOrder, false, true>(L3, g, S, E);
    }
#endif
    XCD_SYNC();
#ifndef NO_P6
    {
        pg8::Gemm g{H2B, Wff1_t, nullptr, nullptr, M, FF, DM}; pg8::StaticOrder S; S.init(M, FF, G, bx);
        pg8::EpiP6 E{U, SSQ_H2};
        pg8::gemm_phase<pg8::EpiP6, pg8::StaticOrder, true, true>(L3, g, S, E);
    }
#endif
    XCD_SYNC();
#ifndef NO_P7
    {
        pg8::Gemm g{U, Wff2_t, nullptr, nullptr, M, DM, FF}; pg8::StaticOrder S; S.init(M, DM, G, bx);
        pg8::EpiP7 E{out, SSQ_H3};
        pg8::gemm_phase<pg8::EpiP7, pg8::StaticOrder, false, true>(L3, g, S, E);
    }
#endif
    XCD_SYNC();
#ifndef NO_P8
    {
        pg8::StaticOrder S; S.init(M, DM, G, bx); pg8::Unit u;
        for (int i = 0; S.next(i, u); ++i) {
            const f32x4 gn = *((const f32x4*)(norm_final + u.pn * 256) + lane);
            for (int r = 0; r < 32; ++r) { const int row = u.pm * 256 + wave * 32 + r;
                const float rstd = 1.f / sqrtf(pg8::sum16(SSQ_H3 + (size_t)row * 16) * (1.f / DM) + EPS);
                f32x4* rp = (f32x4*)(out + (size_t)row * DM + u.pn * 256) + lane; *rp = *rp * rstd * gn; }
        }
    }
#endif
}

constexpr int LDS_BYTES = 131072 + 2048;
extern "C" void kernel_launch(void* const* d_in, const int* in_sizes, int n_in, void* d_out, int out_size, void* d_ws, size_t ws_size, hipStream_t stream) {
    static int grid = 0;
    if (grid == 0) {
        if (n_in != 16 || out_size != M * DM || ws_size < WS_END) { fprintf(stderr, "kernel_launch: unexpected shapes (n_in %d out %d ws %zu)\n", n_in, out_size, ws_size); grid = -1; return; }
        int dev = 0, cus = 0, per_cu = 0;
        hipGetDevice(&dev); hipDeviceGetAttribute(&cus, hipDeviceAttributeMultiprocessorCount, dev);
        hipFuncSetAttribute((const void*)mega_fwd, hipFuncAttributeMaxDynamicSharedMemorySize, LDS_BYTES);
        if (hipOccupancyMaxActiveBlocksPerMultiprocessor(&per_cu, (const void*)mega_fwd, NWAVES * 64, LDS_BYTES) != hipSuccess || per_cu < 1) { fprintf(stderr, "kernel_launch: occupancy query failed (%d)\n", per_cu); (void)hipGetLastError(); per_cu = 1; }
        grid = cus;
    }
    if (grid < 0) return;
    if (hipMemsetAsync((char*)d_ws + WS_BAR, 0, 16384, stream) != hipSuccess) { fprintf(stderr, "kernel_launch: memset of the barrier words failed\n"); return; }
    Args a{};
    for (int i = 0; i < 16; ++i) a.in[i] = (const float*)d_in[i];
    a.out = (float*)d_out; a.ws = (unsigned char*)d_ws;
    void* args[] = {&a};
    hipError_t e = hipLaunchCooperativeKernel((const void*)mega_fwd, dim3(grid), dim3(NWAVES * 64), args, LDS_BYTES, stream);
    if (e != hipSuccess) fprintf(stderr, "kernel_launch: cooperative launch failed: %s (grid %d)\n", hipGetErrorString(e), grid);
}
```

```cpp
#include <hip/hip_runtime.h>
#include <hip/hip_cooperative_groups.h>
#include <cstdio>
#include <cstdint>
constexpr int NWAVES = 8;
constexpr int BATCH = 4, SEQ = 4096, DM = 1024, NMETA = 16, M = BATCH * SEQ, KPB = 4224  , LTOT = 4112;
constexpr int D_IN = 4256, N_IN = 4352, FF = 4096;
constexpr float EPS = 1e-6f;
constexpr size_t MiB = 1u << 20;
constexpr size_t WS_ROPE = 0, WS_MP = 786432, WS_BAR = 917504  ;
constexpr size_t WS_WIN = 1 * MiB, WS_WUQ = 9 * MiB + 512 * 1024, WS_WUKV = 10 * MiB + 256 * 1024, WS_WNA = 11 * MiB, WS_WMLA = 12 * MiB, WS_WOUT = 13 * MiB, WS_WFF1 = 15 * MiB, WS_WFF2 = 23 * MiB;
constexpr size_t WS_SSQ_CKV = 31 * MiB;
constexpr size_t WS_HN = 32 * MiB, WS_MG = 32 * MiB;
constexpr size_t WS_QNA = 64 * MiB, WS_H2B = 64 * MiB, WS_KNA = 80 * MiB, WS_VNA = 96 * MiB + 512 * 1024, WS_QM = 113 * MiB, WS_KM = 137 * MiB, WS_VM = 162 * MiB;
constexpr size_t WS_GNA = 179 * MiB, WS_GMLA = 211 * MiB, WS_SSQ_CQ = 243 * MiB, WS_SSQ_H2 = 244 * MiB, WS_SSQ_H3 = 245 * MiB, WS_END = 256 * MiB;
constexpr size_t WS_U = 97 * MiB;
constexpr size_t DO_CQ = 0, DO_CKV = 12 * MiB, DO_T = 0, DO_ONA = 32 * MiB, DO_OMLA = 48 * MiB;
static_assert(WS_WIN + (size_t)N_IN * DM * 2 <= WS_WUQ && WS_WUQ + 768 * 384 * 2 <= WS_WUKV && WS_WUKV + 1024 * 256 * 2 <= WS_WNA && WS_WFF2 + (size_t)DM * FF * 2 <= WS_SSQ_CKV, "weights map");
static_assert(WS_SSQ_CKV + (size_t)M * 8 * 4 <= WS_HN && WS_KNA + (size_t)BATCH * KPB * 512 * 2 <= WS_VNA && WS_VNA + (size_t)BATCH * KPB * 512 * 2 <= WS_QM && WS_QM + (size_t)M * 768 * 2 <= WS_KM, "map 1");
static_assert(WS_KM + (size_t)BATCH * KPB * 768 * 2 <= WS_VM && WS_VM + (size_t)BATCH * KPB * 512 * 2 <= WS_GNA && WS_GMLA + (size_t)M * DM * 2 <= WS_SSQ_CQ && WS_SSQ_H3 + (size_t)M * 64 <= WS_END, "map 2");
static_assert(WS_U + (size_t)M * FF * 2 <= WS_SSQ_CQ && WS_H2B + (size_t)M * DM * 2 <= WS_U && WS_MP + 16 * 1312 * 4 <= WS_WIN && (size_t)LTOT * 32 * 4 <= WS_MP && DO_CKV + (size_t)M * 256 * 2 <= DO_ONA, "map 3");
namespace pg8 {
#define PG8_LAS __attribute__((address_space(3)))
typedef unsigned short bf16_t;
typedef short bf16x8 __attribute__((ext_vector_type(8)));
typedef float f32x4 __attribute__((ext_vector_type(4)));
typedef unsigned u32x4 __attribute__((ext_vector_type(4)));
constexpr int BM = 256, BK = 64, HALF = 128, HTB = HALF * BK * 2  , STAGE_BYTES = 8 * HTB, NXCD = 8, WGM = 8;

__host__ __device__ __forceinline__ int lds_byte(int r, int c) { const int st = (r >> 4) * 2 + (c >> 5), rr = r & 15, cc = c & 31, ob = rr * 64 + cc * 2; return st * 1024 + (ob ^ (((ob >> 9) & 1) << 5)); }
__host__ __device__ __forceinline__ void stage_rc(int b, int& R, int& C) { const int st = b / 1024, sb = b % 1024, swz = sb ^ (((sb >> 9) & 1) << 5); R = (st >> 1) * 16 + swz / 64; C = (st & 1) * 32 + (swz % 64) / 2; }
__host__ __device__ __forceinline__ int perm32(int rho) { const int n = rho >> 4, i = rho & 15; return 8 * (i >> 2) + 4 * n + (i & 3); }

struct Unit { int pm, pn, g; };
struct Gemm { const bf16_t* A; const bf16_t* Bt; const bf16_t* A1; const bf16_t* Bt1; int M, N, K; };

struct StaticOrder {
    int nM, nN, nwg, G, c;
    __host__ __device__ __forceinline__ void init(int M, int N, int G_, int c_) { nM = M / BM; nN = N / BM; nwg = nM * nN; G = G_; c = c_; }
    __host__ __device__ __forceinline__ bool next(int i, Unit& u) const {
        const long L = (long)i * G + c; if (L >= nwg) return false;
        int wgid = (int)L; { const int q = nwg / NXCD, r = nwg % NXCD, xcd = wgid % NXCD, off = wgid / NXCD; wgid = (xcd < r ? xcd * (q + 1) : r * (q + 1) + (xcd - r) * q) + off; }
        const int nig = WGM * nN, gid = wgid / nig, fm = gid * WGM, gsz = (nM - fm) < WGM ? (nM - fm) : WGM;
        u.pm = fm + ((wgid % nig) % gsz); u.pn = (wgid % nig) / gsz; u.g = 0; return true;
    }
    __device__ __forceinline__ void a_ready(const Unit&) const {}
    __device__ __forceinline__ void done(const Unit&) const {}
};

typedef float f32x2 __attribute__((ext_vector_type(2)));
typedef __bf16 bf16x2_cv __attribute__((ext_vector_type(2)));
__device__ __forceinline__ unsigned cvt_pk_bf16(float lo, float hi) { const f32x2 v = {lo, hi}; const bf16x2_cv b = __builtin_convertvector(v, bf16x2_cv); return __builtin_bit_cast(unsigned, b); }
__device__ __forceinline__ u32x4 pack8(const f32x4 a, const f32x4 b) { u32x4 w; w.x = cvt_pk_bf16(a[0], a[1]); w.y = cvt_pk_bf16(a[2], a[3]); w.z = cvt_pk_bf16(b[0], b[1]); w.w = cvt_pk_bf16(b[2], b[3]); return w; }
__device__ __forceinline__ void unpack8(const u32x4 w, f32x4& a, f32x4& b) {
    a[0] = __uint_as_float(w.x << 16); a[1] = __uint_as_float(w.x & 0xffff0000u); a[2] = __uint_as_float(w.y << 16); a[3] = __uint_as_float(w.y & 0xffff0000u);
    b[0] = __uint_as_float(w.z << 16); b[1] = __uint_as_float(w.z & 0xffff0000u); b[2] = __uint_as_float(w.w << 16); b[3] = __uint_as_float(w.w & 0xffff0000u); }
__device__ __forceinline__ float sigm(float x) { return __builtin_amdgcn_rcpf(1.f + __builtin_amdgcn_exp2f(-1.4426950408889634f * x)); }
__device__ __forceinline__ f32x4 sigm4(const f32x4 v) { f32x4 r; r[0] = sigm(v[0]); r[1] = sigm(v[1]); r[2] = sigm(v[2]); r[3] = sigm(v[3]); return r; }
__device__ __forceinline__ float sq4(const f32x4 v) { return (v[0] * v[0] + v[1] * v[1]) + (v[2] * v[2] + v[3] * v[3]); }
__device__ __forceinline__ float red_fq(float s) { s += __shfl_xor(s, 16); s += __shfl_xor(s, 32); return s; }
__device__ __forceinline__ int keyrow(int m) { return (m >> 12) * 4224 + 16 + (m & 4095); }
constexpr float RMS_EPS = 1e-6f;
__device__ __forceinline__ u32x4 rope8(const f32x4 x1, const f32x4 x2, const float* rope, int pos, int fq) {
    const f32x4* t = (const f32x4*)(rope + ((size_t)pos * 16 + 4 * fq) * 2); const f32x4 t0 = t[0], t1 = t[1];
    f32x4 o1, o2;
    o1[0] = x1[0] * t0[0] - x2[0] * t0[1]; o2[0] = x2[0] * t0[0] + x1[0] * t0[1];
    o1[1] = x1[1] * t0[2] - x2[1] * t0[3]; o2[1] = x2[1] * t0[2] + x1[1] * t0[3];
    o1[2] = x1[2] * t1[0] - x2[2] * t1[1]; o2[2] = x2[2] * t1[0] + x1[2] * t1[1];
    o1[3] = x1[3] * t1[2] - x2[3] * t1[3]; o2[3] = x2[3] * t1[2] + x1[3] * t1[3];
    return pack8(o1, o2);
}
#define EPI_ROWS _Pragma("unroll") for (int ai = 0; ai < 2; ++ai) _Pragma("unroll") for (int m = 0; m < 4; ++m)

struct EpiP1 {
    static constexpr bool PERM = true, AFTER_DRAIN = false;
    unsigned char* ws; bf16_t *CKV, *CQ, *KM; float *ssq_ckv, *ssq_cq; const float* rope;
    __device__ __forceinline__ void operator()(const f32x4 (&acc)[2][2][4][2], const Unit& u, int wr, int wc, int fr, int fq) const {
        { int t_ = threadIdx.x; asm volatile("" : "+v"(t_)); fr = t_ & 15; fq = (t_ >> 4) & 3; }
        const int row0 = u.pm * BM + wr * 64 + fr;
#pragma unroll
        for (int bj = 0; bj < 2; ++bj) {
            const int ct = u.pn * 2 + bj, cw = wc * 32 + 8 * fq;
            if (ct < 12) {
                const int which = ct >> 2; bf16_t* base = (bf16_t*)(ws + (which == 0 ? WS_QNA : (which == 1 ? WS_KNA : WS_VNA))); const int col = (ct & 3) * 128 + cw;
                EPI_ROWS { const int row = row0 + ai * HALF + m * 16; const int orow = which == 0 ? row : keyrow(row);
                    *(u32x4*)(base + (size_t)orow * 512 + col) = pack8(acc[ai][bj][m][0], acc[ai][bj][m][1]); }
            } else if (ct < 14) {
                const int col = (ct - 12) * 128 + cw, slot = (ct - 12) * 4 + wc;
                EPI_ROWS { const int row = row0 + ai * HALF + m * 16;
                    *(u32x4*)(CKV + (size_t)row * 256 + col) = pack8(acc[ai][bj][m][0], acc[ai][bj][m][1]);
                    const float s = red_fq(sq4(acc[ai][bj][m][0]) + sq4(acc[ai][bj][m][1])); if (fq == 0) ssq_ckv[(size_t)row * 8 + slot] = s; }
            } else if (ct < 30) {
                bf16_t* base = (bf16_t*)(ws + (ct < 22 ? WS_GNA : WS_GMLA)); const int col = ((ct - 14) & 7) * 128 + cw;
                EPI_ROWS { const int row = row0 + ai * HALF + m * 16;
                    *(u32x4*)(base + (size_t)row * 1024 + col) = pack8(sigm4(acc[ai][bj][m][0]), sigm4(acc[ai][bj][m][1])); }
            } else if (ct < 33) {
                const int col = (ct - 30) * 128 + cw, slot = (ct - 30) * 4 + wc;
                EPI_ROWS { const int row = row0 + ai * HALF + m * 16;
                    *(u32x4*)(CQ + (size_t)row * 384 + col) = pack8(acc[ai][bj][m][0], acc[ai][bj][m][1]);
                    const float s = red_fq(sq4(acc[ai][bj][m][0]) + sq4(acc[ai][bj][m][1])); if (fq == 0) ssq_cq[(size_t)row * 16 + slot] = s; }
            } else if (wc == 0) {
                EPI_ROWS { const int row = row0 + ai * HALF + m * 16; const int pos = 16 + (row & 4095);
                    const u32x4 w = rope8(acc[ai][bj][m][0], acc[ai][bj][m][1], rope, pos, fq);
                    bf16_t* kp = KM + (size_t)keyrow(row) * 768 + 64 + 8 * fq;
#pragma unroll
                    for (int h = 0; h < 8; ++h) *(u32x4*)(kp + h * 96) = w; }
            }
        }
    }
};
struct EpiP2Q {
    static constexpr bool PERM = true, AFTER_DRAIN = false;
    bf16_t* QM; const float* ssq_cq; const float* rope;
    __device__ __forceinline__ void operator()(const f32x4 (&acc)[2][2][4][2], const Unit& u, int wr, int wc, int fr, int fq) const {
        { int t_ = threadIdx.x; asm volatile("" : "+v"(t_)); fr = t_ & 15; fq = (t_ >> 4) & 3; }
        const int row0 = u.pm * BM + wr * 64 + fr;
        EPI_ROWS { const int row = row0 + ai * HALF + m * 16;
            const f32x4* sp = (const f32x4*)(ssq_cq + (size_t)row * 16); const f32x4 s0 = sp[0], s1 = sp[1], s2 = sp[2];
            const float ss = ((s0[0] + s0[1]) + (s0[2] + s0[3])) + ((s1[0] + s1[1]) + (s1[2] + s1[3])) + ((s2[0] + s2[1]) + (s2[2] + s2[3]));
            const float rstd = 1.0f / sqrtf(ss * (1.0f / 384.0f) + RMS_EPS);
#pragma unroll
            for (int bj = 0; bj < 2; ++bj) {
                const f32x4 v0 = acc[ai][bj][m][0] * rstd, v1 = acc[ai][bj][m][1] * rstd;
                if (u.pn < 2) { const int c = u.pn * 256 + bj * HALF + wc * 32 + 8 * fq; const int h = c >> 6, d = c & 63;
                    *(u32x4*)(QM + (size_t)row * 768 + h * 96 + d) = pack8(v0, v1); }
                else { const int h = bj * 4 + wc; const int pos = 16 + (row & 4095);
                    *(u32x4*)(QM + (size_t)row * 768 + h * 96 + 64 + 8 * fq) = rope8(v0, v1, rope, pos, fq); }
            } asm volatile("" ::: "memory"); }
    }
};
struct EpiP2KV {
    static constexpr bool PERM = true, AFTER_DRAIN = false;
    bf16_t *KM, *VM; const float* ssq_ckv;
    __device__ __forceinline__ void operator()(const f32x4 (&acc)[2][2][4][2], const Unit& u, int wr, int wc, int fr, int fq) const {
        { int t_ = threadIdx.x; asm volatile("" : "+v"(t_)); fr = t_ & 15; fq = (t_ >> 4) & 3; }
        const int row0 = u.pm * BM + wr * 64 + fr;
        EPI_ROWS { const int row = row0 + ai * HALF + m * 16; const size_t kr = (size_t)keyrow(row);
            const f32x4* sp = (const f32x4*)(ssq_ckv + (size_t)row * 8); const f32x4 s0 = sp[0], s1 = sp[1];
            const float ss = ((s0[0] + s0[1]) + (s0[2] + s0[3])) + ((s1[0] + s1[1]) + (s1[2] + s1[3]));
            const float rstd = 1.0f / sqrtf(ss * (1.0f / 256.0f) + RMS_EPS);
#pragma unroll
            for (int bj = 0; bj < 2; ++bj) {
                const f32x4 v0 = acc[ai][bj][m][0] * rstd, v1 = acc[ai][bj][m][1] * rstd;
                const int c = (u.pn & 1) * 256 + bj * HALF + wc * 32 + 8 * fq;
                if (u.pn < 2) { const int h = c >> 6, d = c & 63; *(u32x4*)(KM + kr * 768 + h * 96 + d) = pack8(v0, v1); }
                else *(u32x4*)(VM + kr * 512 + c) = pack8(v0, v1);
            } asm volatile("" ::: "memory"); }
    }
};
struct EpiP4 {
    static constexpr bool PERM = true, AFTER_DRAIN = false;
    unsigned char* ws; bf16_t* T; bf16_t* MG; int g;
    __device__ __forceinline__ void operator()(const f32x4 (&acc)[2][2][4][2], const Unit& u, int wr, int wc, int fr, int fq) const {
        { int t_ = threadIdx.x; asm volatile("" : "+v"(t_)); fr = t_ & 15; fq = (t_ >> 4) & 3; }
        const int row0 = u.pm * BM + wr * 64 + fr, col0 = u.pn * BM + wc * 32 + 8 * fq;
        EPI_ROWS { const int row = row0 + ai * HALF + m * 16;
#pragma unroll
            for (int bj = 0; bj < 2; ++bj) { const size_t off = (size_t)row * 1024 + col0 + bj * HALF;
                f32x4 g0, g1; unpack8(*(const u32x4*)((const bf16_t*)(ws + (g ? WS_GMLA : WS_GNA)) + off), g0, g1);
                const f32x4 v0 = acc[ai][bj][m][0] * g0, v1 = acc[ai][bj][m][1] * g1;
                if (g == 0) *(u32x4*)(T + off) = pack8(v0, v1);
                else { f32x4 t0, t1; unpack8(*(const u32x4*)(T + off), t0, t1); *(u32x4*)(MG + off) = pack8(t0 + v0, t1 + v1); }
            } asm volatile("" ::: "memory"); }
    }
};
struct EpiP5 {
    static constexpr bool PERM = true, AFTER_DRAIN = false;
    const float* X; bf16_t* H2B; float* ssq;
    __device__ __forceinline__ void operator()(const f32x4 (&acc)[2][2][4][2], const Unit& u, int wr, int wc, int fr, int fq) const {
        { int t_ = threadIdx.x; asm volatile("" : "+v"(t_)); fr = t_ & 15; fq = (t_ >> 4) & 3; }
        const int row0 = u.pm * BM + wr * 64 + fr, col0 = u.pn * BM + wc * 32 + 8 * fq;
        EPI_ROWS { const int row = row0 + ai * HALF + m * 16; float s = 0.f;
#pragma unroll
            for (int bj = 0; bj < 2; ++bj) { const size_t off = (size_t)row * 1024 + col0 + bj * HALF;
                const f32x4 v0 = *(const f32x4*)(X + off) + acc[ai][bj][m][0], v1 = *(const f32x4*)(X + off + 4) + acc[ai][bj][m][1];
                *(u32x4*)(H2B + off) = pack8(v0, v1); s += sq4(v0) + sq4(v1); }
            s = red_fq(s); if (fq == 0) ssq[(size_t)row * 16 + u.pn * 4 + wc] = s; asm volatile("" ::: "memory"); }
    }
};
__device__ __forceinline__ float sum16(const float* p) { const f32x4* q = (const f32x4*)p; const f32x4 a = q[0], b = q[1], c = q[2], d = q[3];
    return (((a[0] + a[1]) + (a[2] + a[3])) + ((b[0] + b[1]) + (b[2] + b[3]))) + (((c[0] + c[1]) + (c[2] + c[3])) + ((d[0] + d[1]) + (d[2] + d[3]))); }
struct EpiP6 {
    static constexpr bool PERM = true, AFTER_DRAIN = false;
    bf16_t* U; const float* ssq;
    __device__ __forceinline__ void operator()(const f32x4 (&acc)[2][2][4][2], const Unit& u, int wr, int wc, int fr, int fq) const {
        { int t_ = threadIdx.x; asm volatile("" : "+v"(t_)); fr = t_ & 15; fq = (t_ >> 4) & 3; }
        const int row0 = u.pm * BM + wr * 64 + fr, col0 = u.pn * BM + wc * 32 + 8 * fq;
        EPI_ROWS { const int row = row0 + ai * HALF + m * 16;
            const float rstd = 1.0f / sqrtf(sum16(ssq + (size_t)row * 16) * (1.0f / 1024.0f) + RMS_EPS);
#pragma unroll
            for (int bj = 0; bj < 2; ++bj) { const size_t off = (size_t)row * 4096 + col0 + bj * HALF;
                f32x4 v0 = acc[ai][bj][m][0] * rstd, v1 = acc[ai][bj][m][1] * rstd;
#pragma unroll
                for (int e = 0; e < 4; ++e) { const float a = fmaxf(v0[e], 0.f), b = fmaxf(v1[e], 0.f); v0[e] = a * a; v1[e] = b * b; }
                *(u32x4*)(U + off) = pack8(v0, v1); } asm volatile("" ::: "memory"); }
    }
};
struct EpiP7 {
    static constexpr bool PERM = true, AFTER_DRAIN = false;
    const bf16_t* H2B; float* H; float* ssq;
    __device__ __forceinline__ void operator()(const f32x4 (&acc)[2][2][4][2], const Unit& u, int wr, int wc, int fr, int fq) const {
        { int t_ = threadIdx.x; asm volatile("" : "+v"(t_)); fr = t_ & 15; fq = (t_ >> 4) & 3; }
        const int row0 = u.pm * BM + wr * 64 + fr, col0 = u.pn * BM + wc * 32 + 8 * fq;
        EPI_ROWS { const int row = row0 + ai * HALF + m * 16; float s = 0.f;
#pragma unroll
            for (int bj = 0; bj < 2; ++bj) { const size_t off = (size_t)row * 1024 + col0 + bj * HALF;
                f32x4 h0, h1; unpack8(*(const u32x4*)(H2B + off), h0, h1); const f32x4 v0 = h0 + acc[ai][bj][m][0], v1 = h1 + acc[ai][bj][m][1];
                *(f32x4*)(H + off) = v0; *(f32x4*)(H + off + 4) = v1; s += sq4(v0) + sq4(v1); }
            s = red_fq(s); if (fq == 0) ssq[(size_t)row * 16 + u.pn * 4 + wc] = s; asm volatile("" ::: "memory"); }
    }
};
struct PairOrder {
    StaticOrder so;
    __device__ __forceinline__ bool next(int i, Unit& u) const { if (!so.next(i >> 1, u)) return false; u.g = i & 1; return true; }
    __device__ __forceinline__ void a_ready(const Unit&) const {}
    __device__ __forceinline__ void done(const Unit&) const {}
};

template <class Epi, class Sched, bool ALIGN_EPI = false, bool SP2 = false>
__device__ __forceinline__ void gemm_phase(PG8_LAS unsigned char* lds, const Gemm g, const Sched& S, const Epi& E) {
    int tid_ = threadIdx.x; asm volatile("" : "+v"(tid_));
    const int tid = tid_, wid = __builtin_amdgcn_readfirstlane(tid >> 6), lane = tid & 63, wr = wid >> 2, wc = wid & 3, fr = lane & 15, fq = lane >> 4;
    int K_ = g.K; asm volatile("" : "+s"(K_));
    const int K = K_, nt = K / BK;
    unsigned voffA[2], voffB[2];
#pragma unroll
    for (int i = 0; i < 2; ++i) { int R, C; stage_rc(tid * 16 + i * 8192, R, C); const int Rb = Epi::PERM ? ((R & ~31) + perm32(R & 31)) : R;
        voffA[i] = (unsigned)(R * K + C) * 2u; voffB[i] = (unsigned)(Rb * K + C) * 2u; }
    const size_t kstep = (size_t)(BK * 2);
    const size_t hstep = (size_t)HALF * K * 2;
    const size_t tstep = 2 * hstep;
    const unsigned ldsw = (unsigned)wid * 1024u;
    const int aoff = lds_byte(wr * 64 + fr, fq * 8), boff = lds_byte(wc * 32 + fr, fq * 8);
#define PG8_SA(b, h) (((b) * 2 + (h)) * HTB)
#define PG8_SB(b, h) ((4 + (b) * 2 + (h)) * HTB)
#define PG8_STAGE(bufoff, gbase, voff) do { _Pragma("unroll") for (int _i = 0; _i < 2; ++_i) \
        __builtin_amdgcn_global_load_lds((const unsigned*)((const char*)(gbase) + (voff)[_i]), (PG8_LAS unsigned*)(lds + (bufoff) + ldsw + _i * 8192), 16, 0, 0); } while (0)
#define PG8_LDA(dst, b, h) do { _Pragma("unroll") for (int m = 0; m < 4; ++m) _Pragma("unroll") for (int k = 0; k < 2; ++k) dst[m][k] = *(const PG8_LAS bf16x8*)(lds + PG8_SA(b, h) + aoff + m * 2048 + k * 1024); } while (0)
#define PG8_LDB(dst, b, h) do { _Pragma("unroll") for (int n = 0; n < 2; ++n) _Pragma("unroll") for (int k = 0; k < 2; ++k) dst[n][k] = *(const PG8_LAS bf16x8*)(lds + PG8_SB(b, h) + boff + n * 2048 + k * 1024); } while (0)
#define PG8_MMA(ai, bj, At, Bt) do { __builtin_amdgcn_s_setprio(1); _Pragma("unroll") for (int m = 0; m < 4; ++m) _Pragma("unroll") for (int n = 0; n < 2; ++n) _Pragma("unroll") for (int k = 0; k < 2; ++k) \
        acc[ai][bj][m][n] = __builtin_amdgcn_mfma_f32_16x16x32_bf16(Bt[n][k], At[m][k], acc[ai][bj][m][n], 0, 0, 0); __builtin_amdgcn_s_setprio(0); } while (0)
#define PG8_WAIT_V(n) asm volatile("s_waitcnt vmcnt(" #n ")" ::: "memory")
#define PG8_WAIT_L(n) asm volatile("s_waitcnt lgkmcnt(" #n ")" ::: "memory")
#define PG8_BAR __builtin_amdgcn_s_barrier()
#define PG8_SCHED __builtin_amdgcn_sched_barrier(0)
    Unit cur, nxt; int ui = 0;
    if (!S.next(0, cur)) return;
    f32x4 acc[2][2][4][2];
#pragma unroll
    for (int a = 0; a < 2; ++a)
#pragma unroll
        for (int b = 0; b < 2; ++b)
#pragma unroll
            for (int m = 0; m < 4; ++m)
#pragma unroll
                for (int n = 0; n < 2; ++n) acc[a][b][m][n] = (f32x4){0.f, 0.f, 0.f, 0.f};
    bf16x8 At[4][2], B0[2][2], B1[2][2];
    const char* cA = (const char*)(cur.g ? g.A1 : g.A) + (size_t)cur.pm * tstep; const char* cB = (const char*)(cur.g ? g.Bt1 : g.Bt) + (size_t)cur.pn * tstep;
    S.a_ready(cur);
    if constexpr (SP2) {
        PG8_STAGE(PG8_SB(0, 0), cB, voffB); PG8_STAGE(PG8_SB(0, 1), cB + hstep, voffB); PG8_STAGE(PG8_SA(0, 0), cA, voffA); PG8_STAGE(PG8_SA(0, 1), cA + hstep, voffA);
        if (wr == 1) PG8_BAR;
        PG8_WAIT_V(2); PG8_BAR;
        PG8_STAGE(PG8_SB(1, 0), cB + kstep, voffB); PG8_STAGE(PG8_SA(1, 0), cA + kstep, voffA); PG8_STAGE(PG8_SB(1, 1), cB + hstep + kstep, voffB);
        PG8_WAIT_V(6); PG8_BAR;
    } else {
        PG8_STAGE(PG8_SB(0, 0), cB, voffB); PG8_STAGE(PG8_SA(0, 0), cA, voffA); PG8_STAGE(PG8_SB(0, 1), cB + hstep, voffB); PG8_STAGE(PG8_SA(0, 1), cA + hstep, voffA);
        if (wr == 1) PG8_BAR;
        PG8_WAIT_V(4); PG8_BAR;
        PG8_STAGE(PG8_SB(1, 0), cB + kstep, voffB); PG8_STAGE(PG8_SA(1, 0), cA + kstep, voffA); PG8_STAGE(PG8_SB(1, 1), cB + hstep + kstep, voffB);
        PG8_WAIT_V(6); PG8_BAR;
    }
    for (;;) {
        const bool has_next = S.next(ui + 1, nxt);
        const char* nA = has_next ? (const char*)(nxt.g ? g.A1 : g.A) + (size_t)nxt.pm * tstep : cA; const char* nB = has_next ? (const char*)(nxt.g ? g.Bt1 : g.Bt) + (size_t)nxt.pn * tstep : cB;
        for (int t = 0; t < nt; t += 2) {
            const bool last = (t == nt - 2);
            const char* a1 = cA + (size_t)(t + 1) * kstep;
            const char* a2 = last ? nA : cA + (size_t)(t + 2) * kstep; const char* b2 = last ? nB : cB + (size_t)(t + 2) * kstep;
            const char* a3 = a2 + kstep; const char* b3 = b2 + kstep;
            if (last && has_next) S.a_ready(nxt);
            if constexpr (SP2) {
            PG8_LDB(B0, 0, 0); PG8_LDB(B1, 0, 1); PG8_SCHED; PG8_LDA(At, 0, 0); PG8_STAGE(PG8_SA(1, 1), a1 + hstep, voffA);
            PG8_WAIT_V(8); PG8_WAIT_L(0); PG8_BAR; PG8_MMA(0, 0, At, B0); PG8_MMA(0, 1, At, B1); PG8_BAR; PG8_SCHED;
            PG8_LDA(At, 0, 1); PG8_STAGE(PG8_SB(0, 0), b2, voffB); PG8_STAGE(PG8_SB(0, 1), b2 + hstep, voffB); PG8_STAGE(PG8_SA(0, 0), a2, voffA);
            PG8_WAIT_V(8); PG8_WAIT_L(0); PG8_BAR; PG8_MMA(1, 0, At, B0); PG8_MMA(1, 1, At, B1); PG8_BAR; PG8_SCHED;
            PG8_LDB(B0, 1, 0); PG8_LDB(B1, 1, 1); PG8_SCHED; PG8_LDA(At, 1, 0); PG8_STAGE(PG8_SA(0, 1), a2 + hstep, voffA);
            PG8_WAIT_V(8); PG8_WAIT_L(0); PG8_BAR; PG8_MMA(0, 0, At, B0); PG8_MMA(0, 1, At, B1); PG8_BAR; PG8_SCHED;
            PG8_LDA(At, 1, 1); PG8_STAGE(PG8_SB(1, 0), b3, voffB); PG8_STAGE(PG8_SB(1, 1), b3 + hstep, voffB); PG8_STAGE(PG8_SA(1, 0), a3, voffA);
            PG8_WAIT_V(8); PG8_WAIT_L(0); PG8_BAR; PG8_MMA(1, 0, At, B0); PG8_MMA(1, 1, At, B1); PG8_BAR; PG8_SCHED;
            } else {
            PG8_LDB(B0, 0, 0); PG8_SCHED; PG8_LDA(At, 0, 0); PG8_STAGE(PG8_SA(1, 1), a1 + hstep, voffA);
            PG8_WAIT_L(8); PG8_BAR; PG8_WAIT_L(0); PG8_MMA(0, 0, At, B0); PG8_BAR; PG8_SCHED;
            PG8_LDB(B1, 0, 1); PG8_STAGE(PG8_SB(0, 0), b2, voffB);
            PG8_BAR; PG8_WAIT_L(0); PG8_MMA(0, 1, At, B1); PG8_BAR;
            PG8_LDA(At, 0, 1); PG8_STAGE(PG8_SA(0, 0), a2, voffA);
            PG8_BAR; PG8_WAIT_L(0); PG8_MMA(1, 0, At, B0); PG8_BAR; PG8_SCHED;
            PG8_STAGE(PG8_SB(0, 1), b2 + hstep, voffB);
            PG8_WAIT_V(6); PG8_BAR; PG8_MMA(1, 1, At, B1); PG8_BAR;
            PG8_LDB(B0, 1, 0); PG8_SCHED; PG8_LDA(At, 1, 0); PG8_STAGE(PG8_SA(0, 1), a2 + hstep, voffA);
            PG8_WAIT_L(8); PG8_BAR; PG8_WAIT_L(0); PG8_MMA(0, 0, At, B0); PG8_BAR; PG8_SCHED;
            PG8_LDB(B1, 1, 1); PG8_STAGE(PG8_SB(1, 0), b3, voffB);
            PG8_BAR; PG8_WAIT_L(0); PG8_MMA(0, 1, At, B1); PG8_BAR;
            PG8_LDA(At, 1, 1); PG8_STAGE(PG8_SA(1, 0), a3, voffA);
            PG8_BAR; PG8_WAIT_L(0); PG8_MMA(1, 0, At, B0); PG8_BAR; PG8_SCHED;
            PG8_STAGE(PG8_SB(1, 1), b3 + hstep, voffB);
            PG8_WAIT_V(6); PG8_BAR; PG8_MMA(1, 1, At, B1); PG8_BAR;
            }
        }
        if constexpr (ALIGN_EPI) { if (wr == 0) PG8_BAR; }
        if constexpr (!Epi::AFTER_DRAIN) { E(acc, cur, wr, wc, fr, fq); S.done(cur); }
        if (!has_next) break;
#pragma unroll
        for (int a = 0; a < 2; ++a)
#pragma unroll
            for (int b = 0; b < 2; ++b)
#pragma unroll
                for (int m = 0; m < 4; ++m)
#pragma unroll
                    for (int n = 0; n < 2; ++n) acc[a][b][m][n] = (f32x4){0.f, 0.f, 0.f, 0.f};
        cur = nxt; cA = nA; cB = nB; ++ui;
        if constexpr (ALIGN_EPI) { if (wr == 1) PG8_BAR; }
    }
    PG8_WAIT_V(0);
    if constexpr (!ALIGN_EPI) { if (wr == 0) PG8_BAR; }
    PG8_BAR;
    if constexpr (Epi::AFTER_DRAIN) { E.fused(acc, cur, wr, wc, fr, fq, lds, wid, lane); S.done(cur); }
#undef PG8_SA
#undef PG8_SB
#undef PG8_STAGE
#undef PG8_LDA
#undef PG8_LDB
#undef PG8_MMA
#undef PG8_WAIT_V
#undef PG8_WAIT_L
#undef PG8_BAR
#undef PG8_SCHED
}
}
namespace att {
typedef unsigned short bf16_t;
using bf16x8 = __attribute__((ext_vector_type(8))) short;
using s16x4  = __attribute__((ext_vector_type(4))) short;
using f32x16 = __attribute__((ext_vector_type(16))) float;
using u32x4  = __attribute__((ext_vector_type(4))) unsigned;
#define KSWZ(row, colB) ((row) * 256 + ((colB) ^ (((row) & 7) << 4)))
#define SBAR() __builtin_amdgcn_sched_barrier(0)
constexpr float NEGV = -1e30f, THR = 8.f;
__device__ __forceinline__ int crow(int r, int hi) { return (r & 3) + 8 * (r >> 2) + 4 * hi; }
typedef float f32x2_cv __attribute__((ext_vector_type(2))); typedef __bf16 bf16x2_cv __attribute__((ext_vector_type(2)));
__device__ __forceinline__ unsigned cvtpk(float lo, float hi) { const f32x2_cv v = {lo, hi}; const bf16x2_cv b = __builtin_convertvector(v, bf16x2_cv); return __builtin_bit_cast(unsigned, b); }
template <int DQK> struct Cfg { static constexpr float SCALE = (DQK == 96) ? 0.10206207261596577f : 0.125f; };

template <int DQK> __device__ __forceinline__ void partialSM(f32x16& p0, f32x16& p1, float& m_reg, float& mn, float& alpha) {
  constexpr float SCALE = Cfg<DQK>::SCALE, C = SCALE * 1.4426950408889634f;
  float pmax = p0[0];
#pragma unroll
  for (int r = 1; r < 16; ++r) pmax = fmaxf(pmax, p0[r]);
#pragma unroll
  for (int r = 0; r < 16; ++r) pmax = fmaxf(pmax, p1[r]);
  { auto rr = __builtin_amdgcn_permlane32_swap(__float_as_uint(pmax), __float_as_uint(pmax), false, false);
    pmax = fmaxf(__uint_as_float(rr[0]), __uint_as_float(rr[1])); }
  if (__builtin_expect(__all(pmax - m_reg <= THR / SCALE), 1)) { mn = m_reg; alpha = 1.f; }
  else { mn = fmaxf(m_reg, pmax); alpha = __builtin_amdgcn_exp2f((m_reg - mn) * C); m_reg = mn; }
  const float mnC = -mn * C;
#pragma unroll
  for (int r = 0; r < 16; ++r) p0[r] = fmaf(p0[r], C, mnC);
#pragma unroll
  for (int r = 0; r < 16; ++r) p1[r] = fmaf(p1[r], C, mnC);
#pragma unroll
  for (int r = 0; r < 16; ++r) p0[r] = __builtin_amdgcn_exp2f(p0[r]);
}
__device__ __forceinline__ void finishSM(f32x16& p0, f32x16& p1, float alpha, float& l_reg, bf16x8& pa0, bf16x8& pa1, bf16x8& pa2, bf16x8& pa3) {
#pragma unroll
  for (int r = 0; r < 16; ++r) p1[r] = __builtin_amdgcn_exp2f(p1[r]);
  float ps = 0;
#pragma unroll
  for (int r = 0; r < 16; ++r) ps += p0[r];
#pragma unroll
  for (int r = 0; r < 16; ++r) ps += p1[r];
  { auto rr = __builtin_amdgcn_permlane32_swap(__float_as_uint(ps), __float_as_uint(ps), false, false);
    ps = __uint_as_float(rr[0]) + __uint_as_float(rr[1]); }
  l_reg = l_reg * alpha + ps;
#define PK4(P, BASE, OUT) do { unsigned a0 = cvtpk(P[BASE + 0], P[BASE + 1]), a1 = cvtpk(P[BASE + 2], P[BASE + 3]);   \
    unsigned b0 = cvtpk(P[BASE + 4], P[BASE + 5]), b1 = cvtpk(P[BASE + 6], P[BASE + 7]);                              \
    auto r0 = __builtin_amdgcn_permlane32_swap(a0, b0, false, false); auto r1 = __builtin_amdgcn_permlane32_swap(a1, b1, false, false); \
    u32x4 w = {r0[0], r1[0], r0[1], r1[1]}; OUT = *reinterpret_cast<bf16x8*>(&w); } while (0)
  PK4(p0, 0, pa0); PK4(p0, 8, pa1); PK4(p1, 0, pa2); PK4(p1, 8, pa3);
#undef PK4
}
template <int DQK> __device__ __forceinline__ void qkt(f32x16& p0, f32x16& p1, const char* Ks, const bf16x8* qr, int r32, int hi) {
  p0 = f32x16{}; p1 = f32x16{};
#pragma unroll
  for (int d0 = 0; d0 < DQK / 16; ++d0) { const int cb = (d0 * 16 + hi * 8) * 2;
    const bf16x8 b0 = *reinterpret_cast<const bf16x8*>(Ks + KSWZ(r32, cb));
    const bf16x8 b1 = *reinterpret_cast<const bf16x8*>(Ks + KSWZ(32 + r32, cb));
    p0 = __builtin_amdgcn_mfma_f32_32x32x16_bf16(b0, qr[d0], p0, 0, 0, 0);
    p1 = __builtin_amdgcn_mfma_f32_32x32x16_bf16(b1, qr[d0], p1, 0, 0, 0); }
}
__device__ __forceinline__ int v_st(int k, int c) { const int kk = (k & ~0xC) | ((k & 4) << 1) | ((k & 8) >> 1); return ((kk >> 3) * 4 + (c >> 5)) * 512 + ((kk & 7) * 32 + (c & 31)) * 2; }
__device__ __forceinline__ int v_rd_base(int lane) { return ((lane & 3) << 3) | (((lane >> 2) & 3) << 6) | (((lane >> 4) & 1) << 5) | (((lane >> 5) & 1) << 8); }
constexpr int v_rd_off(int d0, int ks, int half) { return d0 * 512 + ks * 4096 + half * 2048; }
template <int OFF> __device__ __forceinline__ s16x4 tr_read(int vb) {
  s16x4 r; asm volatile("ds_read_b64_tr_b16 %0, %1 offset:%2" : "=&v"(r) : "v"(vb), "i"(OFF) : "memory"); return r;
}
template <int D0> __device__ __forceinline__ void pv_one(f32x16& od, int vb, bf16x8 pa0, bf16x8 pa1, bf16x8 pa2, bf16x8 pa3) {
  const s16x4 l0 = tr_read<v_rd_off(D0, 0, 0)>(vb), h0 = tr_read<v_rd_off(D0, 0, 1)>(vb), l1 = tr_read<v_rd_off(D0, 1, 0)>(vb), h1 = tr_read<v_rd_off(D0, 1, 1)>(vb);
  const s16x4 l2 = tr_read<v_rd_off(D0, 2, 0)>(vb), h2 = tr_read<v_rd_off(D0, 2, 1)>(vb), l3 = tr_read<v_rd_off(D0, 3, 0)>(vb), h3 = tr_read<v_rd_off(D0, 3, 1)>(vb);
  asm volatile("s_waitcnt lgkmcnt(0)" ::: "memory"); SBAR();
#define PK(L, H) (bf16x8){L[0], L[1], L[2], L[3], H[0], H[1], H[2], H[3]}
  od = __builtin_amdgcn_mfma_f32_32x32x16_bf16(pa0, PK(l0, h0), od, 0, 0, 0);
  od = __builtin_amdgcn_mfma_f32_32x32x16_bf16(pa1, PK(l1, h1), od, 0, 0, 0);
  od = __builtin_amdgcn_mfma_f32_32x32x16_bf16(pa2, PK(l2, h2), od, 0, 0, 0);
  od = __builtin_amdgcn_mfma_f32_32x32x16_bf16(pa3, PK(l3, h3), od, 0, 0, 0);
#undef PK
}
__device__ __forceinline__ void pv2(f32x16* o, int vb, bf16x8 pa0, bf16x8 pa1, bf16x8 pa2, bf16x8 pa3) {
  pv_one<0>(o[0], vb, pa0, pa1, pa2, pa3); pv_one<1>(o[1], vb, pa0, pa1, pa2, pa3);
}

template <int DQK, bool IS_NA>
__device__ __forceinline__ void attn_unit(const bf16_t* __restrict__ Qb, const bf16_t* __restrict__ Kh, const bf16_t* __restrict__ Vh, bf16_t* Ob,
                                          const int NT, const int r0, const int krow0, const int nkr, const float* __restrict__ rpbh, char* lds) {
  constexpr int LDQ = IS_NA ? 512 : 768, LDK = LDQ, LDV = 512, LDO = 512, ND = DQK / 16, NKC = DQK / 8;
  constexpr bool K2 = (NKC * 64 > 512);
  int tid_ = threadIdx.x; asm volatile("" : "+v"(tid_));
  const int tid = tid_, wid = __builtin_amdgcn_readfirstlane(tid >> 6), lane = tid & 63, r32 = lane & 31, hi = lane >> 5;
  char* V_lds = lds; char* K_lds = lds + 32768;
  float* ws = (float*)(lds + 65536) + wid * 64; float* li_l = ws; float* al_l = ws + 32;
  float* tab = (float*)(lds + 65536 + 2048);
  if constexpr (IS_NA) { for (int i = tid; i < 15 * 128; i += 512) { const int dr = i >> 7, x = (i & 127) - 48; tab[i] = (x >= 0 && x < 31) ? rpbh[dr * 31 + x] * 8.f : 0.f; } }
  const int myrow = r0 + (wid >> 1), rs = min(max(myrow - 4, 0), 56), cq = (wid & 1) * 32 + r32, lo = min(max(cq - 8, 0), 48);
  float m_reg = -1e30f, l_reg = 0; f32x16 o[2]; o[0] = f32x16{}; o[1] = f32x16{}; bf16x8 qr[ND];
  const bf16_t* Qw = Qb + (size_t)(wid * 32 + r32) * LDQ + hi * 8;
#pragma unroll
  for (int d0 = 0; d0 < ND; ++d0) qr[d0] = *reinterpret_cast<const bf16x8*>(Qw + d0 * 16);
  const int kr0 = tid / NKC, kc0 = tid % NKC;
  const int ck1 = (tid + 512 < NKC * 64) ? tid + 512 : NKC * 64 - 1; const int kr1 = ck1 / NKC, kc1 = ck1 % NKC; const bool k1on = (tid + 512) < NKC * 64;
  const int vr = tid >> 3, vc = (tid & 7) * 8;
  const int vst = v_st(vr, vc), kst0 = KSWZ(kr0, kc0 * 16), kst1 = KSWZ(kr1, kc1 * 16);
  const int vb0 = (int)(uintptr_t)V_lds + v_rd_base(lane);
  struct { bf16x8 vs0, ks0, ks1; } sr_[2];
#define KEYBASE(j) (IS_NA ? ((j) == 0 ? 0 : 16 + 64 * min(krow0 + (j) - 1, krow0 + nkr - 1)) : 64 * (j))
#define SLOAD(i, j) do { const int kb_ = KEYBASE(j); sr_[i].ks0 = *reinterpret_cast<const bf16x8*>(Kh + (size_t)(kb_ + kr0) * LDK + kc0 * 8); \
    if (K2) sr_[i].ks1 = *reinterpret_cast<const bf16x8*>(Kh + (size_t)(kb_ + kr1) * LDK + kc1 * 8); \
    sr_[i].vs0 = *reinterpret_cast<const bf16x8*>(Vh + (size_t)(kb_ + vr) * LDV + vc); } while (0)
#define SWRITE(b, i) do { *(bf16x8*)(K_lds + (b) * 16384 + kst0) = sr_[i].ks0; if (K2 && k1on) *(bf16x8*)(K_lds + (b) * 16384 + kst1) = sr_[i].ks1; \
    *(bf16x8*)(V_lds + (b) * 16384 + vst) = sr_[i].vs0; } while (0)
#define SWAIT() do { if (K2) asm volatile("s_waitcnt vmcnt(3)" ::: "memory"); else asm volatile("s_waitcnt vmcnt(2)" ::: "memory"); } while (0)
#define RESC(a) do { if (__any((a) < 1.f)) { if (hi == 0) al_l[r32] = (a); asm volatile("s_waitcnt lgkmcnt(0)" ::: "memory"); \
    _Pragma("unroll") for (int d = 0; d < 2; ++d) _Pragma("unroll") for (int r = 0; r < 16; ++r) o[d][r] *= al_l[crow(r, hi)]; } } while (0)
#define MASK(P0, P1, j) do { \
    if (!IS_NA) { if ((j) >= 64) { const int kb_ = 64 * (j) + 4 * hi; \
        _Pragma("unroll") for (int r = 0; r < 16; ++r) { const int kv = kb_ + (r & 3) + 8 * (r >> 2); if (kv >= 4112) P0[r] = NEGV; if (kv + 32 >= 4112) P1[r] = NEGV; } } } \
    else if ((j) == 0) { _Pragma("unroll") for (int r = 0; r < 16; ++r) { const int kc = (r & 3) + 8 * (r >> 2) + 4 * hi; if (kc >= 16) P0[r] = NEGV; P1[r] = NEGV; } } \
    else { const int kr_ = krow0 + (j) - 1; const bool ok_ = ((j) - 1 < nkr) && (kr_ >= rs) && (kr_ < rs + 8); \
      if (!ok_) { _Pragma("unroll") for (int r = 0; r < 16; ++r) { P0[r] = NEGV; P1[r] = NEGV; } } \
      else { const float* tb_ = tab + (kr_ - myrow + 7) * 128 + (63 - cq) + 4 * hi; const int kl_ = 4 * hi - lo; \
        _Pragma("unroll") for (int r = 0; r < 16; ++r) { const int e = (r & 3) + 8 * (r >> 2); const float b0 = tb_[e], b1 = tb_[e + 32]; \
          P0[r] = ((unsigned)(e + kl_) < 16u) ? P0[r] + b0 : NEGV; P1[r] = ((unsigned)(e + 32 + kl_) < 16u) ? P1[r] + b1 : NEGV; } } } \
  } while (0)
  f32x16 pA0, pA1, pB0, pB1; float mnA, mnB, alA, alB; bf16x8 pa0, pa1, pa2, pa3;
  constexpr int SE = 0, SO = 1;
  SLOAD(SE, 0); asm volatile("s_waitcnt vmcnt(0)" ::: "memory"); SWRITE(0, SE); __syncthreads();
  qkt<DQK>(pA0, pA1, K_lds, qr, r32, hi); MASK(pA0, pA1, 0); partialSM<DQK>(pA0, pA1, m_reg, mnA, alA);
  SLOAD(SO, 1); if (2 < NT) SLOAD(SE, 2);
  SWAIT(); SWRITE(1, SO); __syncthreads();
  for (int j = 1; j + 1 < NT; j += 2) {
    SBAR(); qkt<DQK>(pB0, pB1, K_lds + 16384, qr, r32, hi);
    finishSM(pA0, pA1, alA, l_reg, pa0, pa1, pa2, pa3); SBAR();
    SLOAD(SO, j + 2); SBAR();
    pv2(o, vb0, pa0, pa1, pa2, pa3); MASK(pB0, pB1, j); partialSM<DQK>(pB0, pB1, m_reg, mnB, alB);
    __syncthreads(); SWAIT(); SWRITE(0, SE);
    RESC(alB); __syncthreads();
    SBAR(); qkt<DQK>(pA0, pA1, K_lds, qr, r32, hi);
    finishSM(pB0, pB1, alB, l_reg, pa0, pa1, pa2, pa3); SBAR();
    if (j + 3 < NT) SLOAD(SE, j + 3); SBAR();
    pv2(o, vb0 + 16384, pa0, pa1, pa2, pa3); MASK(pA0, pA1, j + 1); partialSM<DQK>(pA0, pA1, m_reg, mnA, alA);
    __syncthreads(); SWAIT(); SWRITE(1, SO);
    RESC(alA); __syncthreads();
  }
  SBAR(); qkt<DQK>(pB0, pB1, K_lds + 16384, qr, r32, hi);
  finishSM(pA0, pA1, alA, l_reg, pa0, pa1, pa2, pa3); SBAR();
  pv2(o, vb0, pa0, pa1, pa2, pa3); MASK(pB0, pB1, NT - 1); partialSM<DQK>(pB0, pB1, m_reg, mnB, alB);
  __syncthreads(); RESC(alB);
  finishSM(pB0, pB1, alB, l_reg, pa0, pa1, pa2, pa3); SBAR();
  pv2(o, vb0 + 16384, pa0, pa1, pa2, pa3);
  if (hi == 0) li_l[r32] = l_reg; asm volatile("s_waitcnt lgkmcnt(0)" ::: "memory");
  float rli[16];
#pragma unroll
  for (int r = 0; r < 16; ++r) rli[r] = __builtin_amdgcn_rcpf(li_l[crow(r, hi)]);
  bf16_t* Ow = Ob + (size_t)(wid * 32) * LDO;
#pragma unroll
  for (int r = 0; r < 16; ++r) { const int orow = crow(r, hi);
#pragma unroll
    for (int d0 = 0; d0 < 2; ++d0) Ow[(size_t)orow * LDO + d0 * 32 + r32] = (bf16_t)(cvtpk(o[d0][r] * rli[r], 0.f) & 0xffffu); }
  __syncthreads();
#undef KEYBASE
#undef SLOAD
#undef SWRITE
#undef SWAIT
#undef RESC
#undef MASK
}
#undef KSWZ
#undef SBAR
}
namespace cg = cooperative_groups;
#define LAS __attribute__((address_space(3)))
typedef unsigned short bf16;
typedef unsigned v4u __attribute__((ext_vector_type(4)));
typedef float f32x4 __attribute__((ext_vector_type(4)));
__device__ __forceinline__ unsigned f2bf(float f) { unsigned u = __builtin_bit_cast(unsigned, f); return (u + 0x7fffu + ((u >> 16) & 1u)) >> 16; }
__device__ __forceinline__ unsigned pk2(float lo, float hi) { return f2bf(lo) | (f2bf(hi) << 16); }
__device__ __forceinline__ float wave_sum(float v) {
#pragma unroll
    for (int o = 1; o < 64; o <<= 1) v += __shfl_xor(v, o);
    return v;
}
#define LDS_WAIT() asm volatile("s_waitcnt lgkmcnt(0)" ::: "memory")
__device__ __forceinline__ int pperm(int d) { return d < 16 ? 8 * (d >> 2) + (d & 3) : 8 * ((d - 16) >> 2) + 4 + (d & 3); }
__device__ __forceinline__ int dstcol(int mat, int n) {
    if (mat == 0) { if (n < 1536) return n; if (n < 1920) return n - 1536 + 3840; if (n < 2176) return n - 1920 + 1536; if (n < 2208) return 4224 + pperm(n - 2176); if (n < 3232) return n - 2208 + 1792; return n - 3232 + 2816; }
    if (mat == 1) { const int h = n / 96, j = n % 96; return j < 64 ? h * 64 + j : 512 + h * 32 + pperm(j - 64); }
    if (mat == 2) { const int h = n >> 7, j = n & 127; return j < 64 ? h * 64 + j : 512 + h * 64 + (j - 64); }
    return n;
}
__device__ __forceinline__ void p0_transpose_item(const float* W, int K, int N, bf16* WT, const float* gain, int mat, LAS float* scr, int item, int lane) {
    const int nblk = N / 32, kb = item / nblk, nb = item % nblk, k0 = 64 * kb, n0 = 32 * nb;
#pragma unroll 8
    for (int i = 0; i < 32; ++i) { const int kk = 2 * i + (lane >> 5); const float g = gain ? gain[k0 + kk] : 1.f; scr[kk * 33 + (lane & 31)] = W[(size_t)(k0 + kk) * N + n0 + (lane & 31)] * g; }
    LDS_WAIT(); asm volatile("" ::: "memory");
    const int c = lane & 7;
#pragma unroll
    for (int j = 0; j < 4; ++j) { const int n = (lane >> 3) + 8 * j; const LAS float* s = scr + (8 * c) * 33 + n;
        v4u o; o.x = pk2(s[0 * 33], s[1 * 33]); o.y = pk2(s[2 * 33], s[3 * 33]); o.z = pk2(s[4 * 33], s[5 * 33]); o.w = pk2(s[6 * 33], s[7 * 33]);
        *(v4u*)(WT + (size_t)dstcol(mat, n0 + n) * K + k0 + 8 * c) = o; }
    LDS_WAIT(); asm volatile("" ::: "memory");
}
__device__ __forceinline__ void rms_row_to_bf16(const float* xrow, bf16* orow, int lane) {
    const f32x4* xr = (const f32x4*)xrow + lane;
    f32x4 v[4]; float s = 0.f;
#pragma unroll
    for (int j = 0; j < 4; ++j) { v[j] = xr[64 * j]; s += (v[j].x * v[j].x + v[j].y * v[j].y) + (v[j].z * v[j].z + v[j].w * v[j].w); }
    const float rstd = 1.f / sqrtf(wave_sum(s) * (1.f / DM) + EPS);
    unsigned long long* o8 = (unsigned long long*)orow + lane;
#pragma unroll
    for (int j = 0; j < 4; ++j) o8[64 * j] = (unsigned long long)pk2(v[j].x * rstd, v[j].y * rstd) | ((unsigned long long)pk2(v[j].z * rstd, v[j].w * rstd) << 32);
}

#define XB_TMO      128
#define XB_XCNT(j)  (256  + 64 * (j))
#define XB_XSUB(j)  (1280 + 64 * (j))
#define XB_XGEN(j)  (2304 + 64 * (j))
#define XB_TOP      3328
#define XB_TOPGEN   3392
#define XCD_BAR_WORDS 3456
#define XB_SPIN_CAP (1u << 18)

__device__ __forceinline__ unsigned xb_ld(unsigned* p)              { return __hip_atomic_load(p, __ATOMIC_RELAXED, __HIP_MEMORY_SCOPE_AGENT); }
__device__ __forceinline__ unsigned xb_add(unsigned* p, unsigned v) { return __hip_atomic_fetch_add(p, v, __ATOMIC_RELAXED, __HIP_MEMORY_SCOPE_AGENT); }
__device__ __forceinline__ unsigned xb_xcc_id() { return (unsigned)__builtin_amdgcn_s_getreg((3 << 11) | 20) & 0xFu; }
#define XB_SPIN(cond, bar) do { unsigned _sp = 0; while (cond) { __builtin_amdgcn_s_sleep(1); \
    if ((++_sp & 255u) == 0u) { if (xb_ld(&(bar)[XB_TMO])) break; if (_sp > XB_SPIN_CAP) { atomicAdd(&(bar)[XB_TMO], 1u); break; } } } } while (0)

struct XcdBarrier {
    unsigned* bar; unsigned x;
    volatile LAS unsigned* st;
};

__device__ __forceinline__ XcdBarrier xcd_barrier_post(unsigned* bar, volatile LAS unsigned* st) {
    XcdBarrier b; b.bar = bar; b.x = xb_xcc_id(); b.st = st;
    if (threadIdx.x == 0) (void)xb_add(&bar[XB_XCNT(b.x)], 1u);
    return b;
}
__device__ __forceinline__ void xcd_barrier_complete(unsigned* bar, unsigned x, unsigned& nloc, unsigned& nx) {
    const unsigned G = gridDim.x * gridDim.y * gridDim.z;
    unsigned sum, cnt, mine, sp = 0u;
    for (;;) {
        sum = 0u; cnt = 0u; mine = 0u;
#pragma unroll
        for (unsigned j = 0; j < 16; ++j) { const unsigned c = xb_ld(&bar[XB_XCNT(j)]); sum += c; cnt += (c > 0u) ? 1u : 0u; mine = (j == x) ? c : mine; }
        if (sum == G) break;
        __builtin_amdgcn_s_sleep(1);
        if ((++sp & 255u) == 0u) { if (xb_ld(&bar[XB_TMO])) break; if (sp > XB_SPIN_CAP) { atomicAdd(&bar[XB_TMO], 1u); break; } }
    }
    nloc = mine > 0u ? mine : 1u; nx = cnt > 0u ? cnt : 1u;
}

__device__ __forceinline__ void xcd_barrier(const XcdBarrier& b) {
    asm volatile("s_waitcnt vmcnt(0)" ::: "memory");
    __syncthreads();
    if (threadIdx.x == 0) {
        unsigned* bar = b.bar;
        __builtin_amdgcn_s_waitcnt(0);
        unsigned nloc = b.st[0], nx = b.st[1];
        if (nloc == 0u) { xcd_barrier_complete(bar, b.x, nloc, nx); b.st[0] = nloc; b.st[1] = nx; }
        const unsigned old = xb_add(&bar[XB_XSUB(b.x)], 1u);
        const unsigned gen = old / nloc;
        if (old + 1u == (gen + 1u) * nloc) {
            __builtin_amdgcn_fence(__ATOMIC_RELEASE, "agent");
            asm volatile("s_waitcnt vmcnt(0)" ::: "memory");
            const unsigned og = xb_add(&bar[XB_TOP], 1u);
            const unsigned tg = og / nx;
            if (og + 1u == (tg + 1u) * nx) xb_add(&bar[XB_TOPGEN], 1u);
            else XB_SPIN(xb_ld(&bar[XB_TOPGEN]) == tg, bar);
            __builtin_amdgcn_fence(__ATOMIC_ACQUIRE, "agent");
            xb_add(&bar[XB_XGEN(b.x)], 1u);
            asm volatile("s_waitcnt vmcnt(0)" ::: "memory");
        } else {
            XB_SPIN(xb_ld(&bar[XB_XGEN(b.x)]) == gen, bar);
            __builtin_amdgcn_fence(__ATOMIC_ACQUIRE, "agent");
            asm volatile("s_waitcnt vmcnt(0)" ::: "memory");
        }
    }
    __syncthreads();
}

struct Args { const float* in[16]; float* out; unsigned char* ws; };

__device__ __forceinline__ void meta_part1(const float* meta, const float* norm_mix, const float* w_in, float* MP, LAS float* L, int ci, int tid) {
    const int wave = tid >> 6, lane = tid & 63;
    for (int j = wave; j < 16; j += 8) {
        float x[16]; float s = 0.f;
#pragma unroll
        for (int i = 0; i < 16; ++i) { x[i] = meta[j * 1024 + lane + 64 * i]; s += x[i] * x[i]; }
        const float rstd = 1.f / sqrtf(wave_sum(s) * (1.f / 1024.f) + EPS);
#pragma unroll
        for (int i = 0; i < 16; ++i) L[j * 1024 + lane + 64 * i] = x[i] * rstd * norm_mix[lane + 64 * i];
    }
    __syncthreads();
    const int n0 = ci < 32 ? 512 + 32 * ci : 1920 + 32 * (ci - 32);
    const int col = lane & 31, part = wave * 2 + (lane >> 5), kb = part * 64;
    float acc[16];
#pragma unroll
    for (int j = 0; j < 16; ++j) acc[j] = 0.f;
    for (int k = kb; k < kb + 64; k += 4) {
        const float w0 = w_in[(size_t)k * D_IN + n0 + col], w1 = w_in[(size_t)(k + 1) * D_IN + n0 + col], w2 = w_in[(size_t)(k + 2) * D_IN + n0 + col], w3 = w_in[(size_t)(k + 3) * D_IN + n0 + col];
#pragma unroll
        for (int j = 0; j < 16; ++j) { const f32x4 h = *(const LAS f32x4*)(L + j * 1024 + k); acc[j] += (h.x * w0 + h.y * w1) + (h.z * w2 + h.w * w3); }
    }
#pragma unroll
    for (int j = 0; j < 16; ++j) L[16384 + (part * 16 + j) * 32 + col] = acc[j];
    __syncthreads();
    { const int j = tid >> 5, c = tid & 31; float s = 0.f;
#pragma unroll
      for (int p = 0; p < 16; ++p) s += L[16384 + (p * 16 + j) * 32 + c];
      MP[j * 1312 + 32 * ci + c] = s; }
    __syncthreads();
}
__device__ __forceinline__ void meta_part2(const float* MP, const float* kvn, const float* w_ukv, const float* rope, bf16* KNA, bf16* VNA, bf16* KM, bf16* VM, LAS float* L, int tid) {
    const int wave = tid >> 6, lane = tid & 63;
    for (int idx = tid; idx < 16 * 1024; idx += 512) { const int j = idx >> 10, c = idx & 1023; const bf16 v = (bf16)f2bf(MP[j * 1312 + c]); bf16* dst = c < 512 ? KNA : VNA;
#pragma unroll
        for (int b = 0; b < BATCH; ++b) dst[(size_t)(b * KPB + j) * 512 + (c & 511)] = v; }
    for (int j = wave; j < 16; j += 8) {
        float x[4]; float s = 0.f;
#pragma unroll
        for (int i = 0; i < 4; ++i) { x[i] = MP[j * 1312 + 1024 + lane + 64 * i]; s += x[i] * x[i]; }
        const float rstd = 1.f / sqrtf(wave_sum(s) * (1.f / 256.f) + EPS);
#pragma unroll
        for (int i = 0; i < 4; ++i) L[j * 256 + lane + 64 * i] = x[i] * rstd * kvn[lane + 64 * i];
    }
    __syncthreads();
    for (int q = 0; q < 4; ++q) {
        const int n0 = (wave * 4 + q) * 32, col = lane & 31, half = lane >> 5;
        float acc[16];
#pragma unroll
        for (int j = 0; j < 16; ++j) acc[j] = 0.f;
        for (int k = half * 128; k < half * 128 + 128; k += 4) {
            const float w0 = w_ukv[(size_t)k * 1024 + n0 + col], w1 = w_ukv[(size_t)(k + 1) * 1024 + n0 + col], w2 = w_ukv[(size_t)(k + 2) * 1024 + n0 + col], w3 = w_ukv[(size_t)(k + 3) * 1024 + n0 + col];
#pragma unroll
            for (int j = 0; j < 16; ++j) { const f32x4 h = *(const LAS f32x4*)(L + j * 256 + k); acc[j] += (h.x * w0 + h.y * w1) + (h.z * w2 + h.w * w3); }
        }
#pragma unroll
        for (int j = 0; j < 16; ++j) acc[j] += __shfl_xor(acc[j], 32);
        if (half == 0) { const int n = n0 + col, h = n >> 7, jj = n & 127;
#pragma unroll
            for (int j = 0; j < 16; ++j) { const bf16 v = (bf16)f2bf(acc[j]);
#pragma unroll
                for (int b = 0; b < BATCH; ++b) { if (jj < 64) KM[(size_t)(b * KPB + j) * 768 + h * 96 + jj] = v; else VM[(size_t)(b * KPB + j) * 512 + h * 64 + (jj - 64)] = v; } } }
    }
    if (tid < 256) { const int j = tid >> 4, i = tid & 15; const float x1 = MP[j * 1312 + 1280 + i], x2 = MP[j * 1312 + 1296 + i], c = rope[(j * 16 + i) * 2], s = rope[(j * 16 + i) * 2 + 1];
        const bf16 o1 = (bf16)f2bf(x1 * c - x2 * s), o2 = (bf16)f2bf(x2 * c + x1 * s); const int p1 = pperm(i), p2 = pperm(16 + i);
        for (int b = 0; b < BATCH; ++b) for (int h = 0; h < 8; ++h) { KM[(size_t)(b * KPB + j) * 768 + h * 96 + 64 + p1] = o1; KM[(size_t)(b * KPB + j) * 768 + h * 96 + 64 + p2] = o2; } }
    __syncthreads();
}


#define GRID_SYNC() do { asm volatile("s_waitcnt vmcnt(0)" ::: "memory"); grid.sync(); \
    if (wave == 0) { __builtin_amdgcn_fence(__ATOMIC_ACQUIRE, "agent"); asm volatile("s_waitcnt vmcnt(0)" ::: "memory"); } __syncthreads(); } while (0)
#define XCD_SYNC() xcd_barrier(xbar)
__global__ void __launch_bounds__(NWAVES * 64, 2) mega_fwd(Args a) {
    extern __shared__ __attribute__((aligned(16))) unsigned char lds[];
    cg::grid_group grid = cg::this_grid();
    LAS unsigned char* L3 = (LAS unsigned char*)lds;
    const int tid = threadIdx.x, lane = tid & 63, wave = __builtin_amdgcn_readfirstlane(tid >> 6);
    const int G = gridDim.x, bx = blockIdx.x; const int vcu = (G % 8 == 0) ? (bx % 8) * (G / 8) + bx / 8 : bx;
    unsigned char* ws = a.ws;
    if (tid < 16) ((LAS unsigned*)(L3 + 131072 + 64))[tid] = 0u;
    __syncthreads();
    const XcdBarrier xbar = xcd_barrier_post((unsigned*)(ws + WS_BAR), (volatile LAS unsigned*)(L3 + 131072 + 64));
    const float *x = a.in[0], *meta = a.in[1], *norm_mix = a.in[2], *w_in = a.in[3], *na_rpb = a.in[4], *q_norm = a.in[5], *w_uq = a.in[6], *kv_norm = a.in[7], *w_ukv = a.in[8],
                *w_na_out = a.in[9], *w_mla_out = a.in[10], *w_out = a.in[11], *norm_ffn = a.in[12], *w_ff1 = a.in[13], *w_ff2 = a.in[14], *norm_final = a.in[15];
    float* out = a.out;
    float* ROPE = (float*)(ws + WS_ROPE); float* MP = (float*)(ws + WS_MP);
    bf16 *Win_t = (bf16*)(ws + WS_WIN), *Wuq_t = (bf16*)(ws + WS_WUQ), *Wukv_t = (bf16*)(ws + WS_WUKV), *Wna_t = (bf16*)(ws + WS_WNA), *Wmla_t = (bf16*)(ws + WS_WMLA), *Wout_t = (bf16*)(ws + WS_WOUT),
         *Wff1_t = (bf16*)(ws + WS_WFF1), *Wff2_t = (bf16*)(ws + WS_WFF2);
    bf16 *HN = (bf16*)(ws + WS_HN), *QM = (bf16*)(ws + WS_QM), *MG = (bf16*)(ws + WS_MG), *QNA = (bf16*)(ws + WS_QNA), *H2B = (bf16*)(ws + WS_H2B), *KNA = (bf16*)(ws + WS_KNA), *VNA = (bf16*)(ws + WS_VNA),
         *CQ = (bf16*)((unsigned char*)a.out + DO_CQ), *CKV = (bf16*)((unsigned char*)a.out + DO_CKV), *ONA = (bf16*)((unsigned char*)a.out + DO_ONA), *TB = (bf16*)((unsigned char*)a.out + DO_T), *KM = (bf16*)(ws + WS_KM), *VM = (bf16*)(ws + WS_VM), *GNA = (bf16*)(ws + WS_GNA), *GMLA = (bf16*)(ws + WS_GMLA), *OMLA = (bf16*)((unsigned char*)a.out + DO_OMLA), *U = (bf16*)(ws + WS_U);
    float *SSQ_CKV = (float*)(ws + WS_SSQ_CKV), *SSQ_CQ = (float*)(ws + WS_SSQ_CQ), *SSQ_H2 = (float*)(ws + WS_SSQ_H2), *SSQ_H3 = (float*)(ws + WS_SSQ_H3);

#ifndef NO_P0
    {
        for (int ci = bx; ci < 41; ci += G) meta_part1(meta, norm_mix, w_in, MP, (LAS float*)L3, ci, tid);
        LAS float* scr = (LAS float*)(L3 + wave * 16384);
        const int gw = vcu * NWAVES + wave, NGW = G * NWAVES;
        constexpr int I_IN = (DM / 64) * (D_IN / 32), I_UQ = (384 / 64) * (768 / 32), I_UKV = (256 / 64) * (1024 / 32),
                      NITEMS = I_IN + I_UQ + I_UKV;
        for (int it = gw; it < NITEMS; it += NGW) {
            int r = it;
            if (r < I_IN) { p0_transpose_item(w_in, DM, D_IN, Win_t, norm_mix, 0, scr, r, lane); continue; } r -= I_IN;
            if (r < I_UQ) { p0_transpose_item(w_uq, 384, 768, Wuq_t, q_norm, 1, scr, r, lane); continue; } r -= I_UQ;
            p0_transpose_item(w_ukv, 256, 1024, Wukv_t, kv_norm, 2, scr, r, lane);
        }
        for (int m = gw; m < M; m += NGW) rms_row_to_bf16(x + (size_t)m * DM, HN + (size_t)m * DM, lane);
        const int gt = bx * (NWAVES * 64) + tid, NGT = G * NWAVES * 64;
        for (int e = gt; e < LTOT * 16; e += NGT) {
            const int pos = e >> 4, i = e & 15;
            const float inv = __builtin_amdgcn_exp2f(-(float)i * (13.287712379549449f / 16.0f));
            const float ang = (float)pos * inv;
            double rev = (double)ang * 0.15915494309189535; rev -= __builtin_rint(rev);
            const float rv = (float)rev;
            ROPE[2 * e] = __builtin_amdgcn_cosf(rv); ROPE[2 * e + 1] = __builtin_amdgcn_sinf(rv);
        }
        const v4u z = {0u, 0u, 0u, 0u};
        for (int e = gt; e < 96 * 128; e += NGT) *(v4u*)(Win_t + (size_t)D_IN * DM + (size_t)e * 8) = z;
        for (int e = gt; e < BATCH * 112 * 288; e += NGT) {
            const int c = e % 288, rr = e / 288, b = rr / 112, kr = LTOT + rr % 112; const size_t row = (size_t)b * KPB + kr;
            if (c < 64) *(v4u*)(KNA + row * 512 + c * 8) = z; else if (c < 128) *(v4u*)(VNA + row * 512 + (c - 64) * 8) = z;
            else if (c < 224) *(v4u*)(KM + row * 768 + (c - 128) * 8) = z; else *(v4u*)(VM + row * 512 + (c - 224) * 8) = z;
        }
    }
#endif
    if (a.ws == nullptr) GRID_SYNC();
    XCD_SYNC();
#ifndef NO_P1
    {
        if (bx == G - 1) meta_part2(MP, kv_norm, w_ukv, ROPE, KNA, VNA, KM, VM, (LAS float*)L3, tid);
        pg8::Gemm g{HN, Win_t, nullptr, nullptr, M, N_IN, DM}; pg8::StaticOrder S; S.init(M, N_IN, G, bx);
        pg8::EpiP1 E{ws, CKV, CQ, KM, SSQ_CKV, SSQ_CQ, ROPE};
        pg8::gemm_phase<pg8::EpiP1, pg8::StaticOrder, true, true>(L3, g, S, E);
        { const int nfull = (M / 256) * (N_IN / 256) - 4 * G; const int first = (nfull > 0 && nfull < G) ? nfull : 0;
          if (bx >= first) {
            LAS float* scr = (LAS float*)(L3 + wave * 16384);
            constexpr int I_NA = (512 / 64) * (1024 / 32), I_OUT = (DM / 64) * (DM / 32), I_F1 = (DM / 64) * (FF / 32), I_F2 = (FF / 64) * (DM / 32), NIT2 = 2 * I_NA + I_OUT + I_F1 + I_F2;
            for (int it = (bx - first) * NWAVES + wave; it < NIT2; it += (G - first) * NWAVES) {
                int r = it;
                if (r < I_NA) { p0_transpose_item(w_na_out, 512, 1024, Wna_t, nullptr, 3, scr, r, lane); continue; } r -= I_NA;
                if (r < I_NA) { p0_transpose_item(w_mla_out, 512, 1024, Wmla_t, nullptr, 3, scr, r, lane); continue; } r -= I_NA;
                if (r < I_OUT) { p0_transpose_item(w_out, DM, DM, Wout_t, nullptr, 3, scr, r, lane); continue; } r -= I_OUT;
                if (r < I_F1) { p0_transpose_item(w_ff1, DM, FF, Wff1_t, norm_ffn, 3, scr, r, lane); continue; } r -= I_F1;
                p0_transpose_item(w_ff2, FF, DM, Wff2_t, nullptr, 3, scr, r, lane);
            } } }
    }
#endif
    XCD_SYNC();
#ifndef NO_P2
    {
#ifndef NO_P2A
        { pg8::Gemm g{CQ, Wuq_t, nullptr, nullptr, M, 768, 384}; pg8::StaticOrder S; S.init(M, 768, G, bx);
          pg8::EpiP2Q E{QM, SSQ_CQ, ROPE};
          pg8::gemm_phase<pg8::EpiP2Q, pg8::StaticOrder, false, true>(L3, g, S, E); }
#endif
        __syncthreads();
#ifndef NO_P2B
        { pg8::Gemm g{CKV, Wukv_t, nullptr, nullptr, M, 1024, 256}; pg8::StaticOrder S; S.init(M, 1024, G, bx);
          pg8::EpiP2KV E{KM, VM, SSQ_CKV};
          pg8::gemm_phase<pg8::EpiP2KV, pg8::StaticOrder, false, true>(L3, g, S, E); }
#endif
    }
#endif
    XCD_SYNC();
#ifndef NO_P3
    {
        for (int u = vcu; u < 1024; u += G) {
            if (u < 512) { const int bh = u >> 4, qb = u & 15, b = bh >> 3, h = bh & 7;
                att::attn_unit<96, false>(QM + (size_t)(b * SEQ + 256 * qb) * 768 + h * 96, KM + (size_t)b * KPB * 768 + h * 96, VM + (size_t)b * KPB * 512 + h * 64,
                                          OMLA + (size_t)(b * SEQ + 256 * qb) * 512 + h * 64, 66, 0, 0, 0, nullptr, (char*)lds);
            } else { const int v = u - 512, bh = v >> 4, rg = v & 15, b = bh >> 3, h = bh & 7, r0 = 4 * rg;
                const int krow0 = min(max(r0 - 4, 0), 56), klast = min(max(r0 + 3 - 4, 0), 56) + 7, nkr = klast - krow0 + 1; const int NT = (1 + nkr + 1) & ~1;
                att::attn_unit<64, true>(QNA + (size_t)(b * SEQ + 256 * rg) * 512 + h * 64, KNA + (size_t)b * KPB * 512 + h * 64, VNA + (size_t)b * KPB * 512 + h * 64,
                                         ONA + (size_t)(b * SEQ + 256 * rg) * 512 + h * 64, NT, r0, krow0, nkr, na_rpb + h * 15 * 31, (char*)lds);
            }
        }
    }
#endif
    XCD_SYNC();
#ifndef NO_P4
    {
        pg8::Gemm g{ONA, Wna_t, nullptr, nullptr, M, DM, 512}; pg8::StaticOrder S; S.init(M, DM, G, bx);
        pg8::EpiP4 E{ws, TB, MG, 0};
        pg8::gemm_phase<pg8::EpiP4, pg8::StaticOrder, false, true>(L3, g, S, E);
    }
    XCD_SYNC();
    {
        pg8::Gemm g{OMLA, Wmla_t, nullptr, nullptr, M, DM, 512}; pg8::StaticOrder S; S.init(M, DM, G, bx);
        pg8::EpiP4 E{ws, TB, MG, 1};
        pg8::gemm_phase<pg8::EpiP4, pg8::StaticOrder, false, true>(L3, g, S, E);
    }
#endif
    XCD_SYNC();
#ifndef NO_P5
    {
        pg8::Gemm g{MG, Wout_t, nullptr, nullptr, M, DM, DM}; pg8::StaticOrder S; S.init(M, DM, G, bx);
        pg8::EpiP5 E{x, H2B, SSQ_H2};
        pg8::gemm_phase<pg8::EpiP5, pg8::StaticOrder, false, true>(L3, g, S, E);
    }
#endif
    XCD_SYNC();
#ifndef NO_P6
    {
        pg8::Gemm g{H2B, Wff1_t, nullptr, nullptr, M, FF, DM}; pg8::StaticOrder S; S.init(M, FF, G, bx);
        pg8::EpiP6 E{U, SSQ_H2};
        pg8::gemm_phase<pg8::EpiP6, pg8::StaticOrder, true, true>(L3, g, S, E);
    }
#endif
    XCD_SYNC();
#ifndef NO_P7
    {
        pg8::Gemm g{U, Wff2_t, nullptr, nullptr, M, DM, FF}; pg8::StaticOrder S; S.init(M, DM, G, bx);
        pg8::EpiP7 E{H2B, out, SSQ_H3};
        pg8::gemm_phase<pg8::EpiP7, pg8::StaticOrder, false, true>(L3, g, S, E);
    }
#endif
    XCD_SYNC();
#ifndef NO_P8
    {
        pg8::StaticOrder S; S.init(M, DM, G, bx); pg8::Unit u;
        for (int i = 0; S.next(i, u); ++i) {
            const f32x4 gn = *((const f32x4*)(norm_final + u.pn * 256) + lane);
            for (int r = 0; r < 32; ++r) { const int row = u.pm * 256 + wave * 32 + r;
                const float rstd = 1.f / sqrtf(pg8::sum16(SSQ_H3 + (size_t)row * 16) * (1.f / DM) + EPS);
                f32x4* rp = (f32x4*)(out + (size_t)row * DM + u.pn * 256) + lane; *rp = *rp * rstd * gn; }
        }
    }
#endif
}

constexpr int LDS_BYTES = 131072 + 2048;
extern "C" void kernel_launch(void* const* d_in, const int* in_sizes, int n_in, void* d_out, int out_size, void* d_ws, size_t ws_size, hipStream_t stream) {
    static int grid = 0;
    if (grid == 0) {
        if (n_in != 16 || out_size != M * DM || ws_size < WS_END) { fprintf(stderr, "kernel_launch: unexpected shapes (n_in %d out %d ws %zu)\n", n_in, out_size, ws_size); grid = -1; return; }
        int dev = 0, cus = 0, per_cu = 0;
        hipGetDevice(&dev); hipDeviceGetAttribute(&cus, hipDeviceAttributeMultiprocessorCount, dev);
        hipFuncSetAttribute((const void*)mega_fwd, hipFuncAttributeMaxDynamicSharedMemorySize, LDS_BYTES);
        if (hipOccupancyMaxActiveBlocksPerMultiprocessor(&per_cu, (const void*)mega_fwd, NWAVES * 64, LDS_BYTES) != hipSuccess || per_cu < 1) { fprintf(stderr, "kernel_launch: occupancy query failed (%d)\n", per_cu); (void)hipGetLastError(); per_cu = 1; }
        grid = cus;
    }
    if (grid < 0) return;
    if (hipMemsetAsync((char*)d_ws + WS_BAR, 0, 16384, stream) != hipSuccess) { fprintf(stderr, "kernel_launch: memset of the barrier words failed\n"); return; }
    Args a{};
    for (int i = 0; i < 16; ++i) a.in[i] = (const float*)d_in[i];
    a.out = (float*)d_out; a.ws = (unsigned char*)d_ws;
    void* args[] = {&a};
    hipError_t e = hipLaunchCooperativeKernel((const void*)mega_fwd, dim3(grid), dim3(NWAVES * 64), args, LDS_BYTES, stream);
    if (e != hipSuccess) fprintf(stderr, "kernel_launch: cooperative launch failed: %s (grid %d)\n", hipGetErrorString(e), grid);
}
```
